# Optimizing an MI355X kernel written in HIP

```python
import math
import jax, jax.numpy as jnp
from jax import lax
import numpy as np

D_MODEL = 1024
BATCH = 2
SEQ = 8192
DEPTH = 1
DEC_BATCH = 128
DEC_SEQ = 1
PAST_LEN = 8192
PAGE_SIZE = 128

D_MIX = D_MODEL
D_RNN = D_MIX // 2
N_RNN_BLOCKS = 8
RNN_BLOCK = D_RNN // N_RNN_BLOCKS
CONV_W = 4
LRU_C = 8.0
D_ATT = D_MIX - D_RNN
HEAD_DIM = 64
N_HEADS = D_ATT // HEAD_DIM
N_KV_HEADS = 2
GROUP = N_HEADS // N_KV_HEADS
KV_DIM = N_KV_HEADS * HEAD_DIM
WINDOW = 128
N_BUCKETS = 32
MAX_DISTANCE = 128
EPS = 1e-6
NEG_INF = -1e30
SPLITS = (D_RNN, 2 * D_RNN, 2 * D_RNN + D_ATT, 2 * D_RNN + D_ATT + KV_DIM, 2 * D_RNN + D_ATT + 2 * KV_DIM)
D_IN = 2 * D_RNN + 2 * D_ATT + 2 * KV_DIM

kernel_name = 'hymba_rglru_swa_sink_decode_step'


def rms_norm(x, g):
    xf = x.astype(jnp.float32)
    y = xf * lax.rsqrt(jnp.mean(xf * xf, axis=-1, keepdims=True) + EPS)
    return (y * g.astype(jnp.float32)).astype(x.dtype)


def t5_bucket(dist):
    dist = jnp.maximum(dist, 0)
    max_exact = N_BUCKETS // 2
    d = jnp.maximum(dist, 1).astype(jnp.float32)
    large = max_exact + (jnp.log(d / max_exact) / math.log(MAX_DISTANCE / max_exact)
                         * (N_BUCKETS - max_exact)).astype(jnp.int32)
    large = jnp.minimum(large, N_BUCKETS - 1)
    return jnp.where(dist < max_exact, dist, large)


def rel_bias_from_dist(dist, rel_bias):
    b = rel_bias.astype(jnp.float32)[t5_bucket(dist)]
    return jnp.moveaxis(b, -1, 0).reshape(N_KV_HEADS, GROUP, *dist.shape)


def softmax_with_sink(s, sinks):
    sk = jnp.broadcast_to(sinks.astype(jnp.float32).reshape(N_KV_HEADS, GROUP, 1, 1), s.shape[:-1] + (1,))
    p = jax.nn.softmax(jnp.concatenate([s, sk], axis=-1), axis=-1)
    return p[..., :-1]


def window_attention_prompt(q, k, v, sinks, rel_bias):
    B, S = q.shape[:2]
    nb = S // WINDOW
    qb = q.astype(jnp.float32).reshape(B, nb, WINDOW, N_KV_HEADS, GROUP, HEAD_DIM) * (HEAD_DIM ** -0.5)
    pad = jnp.zeros((B, WINDOW, N_KV_HEADS, HEAD_DIM), jnp.float32)
    kp = jnp.concatenate([pad, k.astype(jnp.float32)], axis=1).reshape(B, nb + 1, WINDOW, N_KV_HEADS, HEAD_DIM)
    vp = jnp.concatenate([pad, v.astype(jnp.float32)], axis=1).reshape(B, nb + 1, WINDOW, N_KV_HEADS, HEAD_DIM)
    kb = jnp.concatenate([kp[:, :-1], kp[:, 1:]], axis=2)
    vb = jnp.concatenate([vp[:, :-1], vp[:, 1:]], axis=2)
    qi = jnp.arange(WINDOW)[:, None]
    kj = jnp.arange(2 * WINDOW)[None, :]
    dist = qi + WINDOW - kj
    band = (dist >= 0) & (dist < WINDOW)
    has_prev = (jnp.arange(nb)[:, None, None] > 0) | (kj >= WINDOW)[None]
    mask = band[None] & has_prev
    bias = rel_bias_from_dist(dist, rel_bias)
    s = jnp.einsum('bnqhgd,bnkhd->bnhgqk', qb, kb) + bias[None, None]
    s = jnp.where(mask[None, :, None, None], s, NEG_INF)
    p = softmax_with_sink(s, sinks)
    o = jnp.einsum('bnhgqk,bnkhd->bnqhgd', p, vb)
    return o.reshape(B, S, D_ATT)


def window_attention_sample(q, k, v, k_buf, v_buf, sinks, rel_bias):
    B, T = q.shape[:2]
    wb = k_buf.shape[1]
    kc = jnp.concatenate([k_buf.astype(k.dtype), k], axis=1)
    vc = jnp.concatenate([v_buf.astype(v.dtype), v], axis=1)
    qf = q.astype(jnp.float32).reshape(B, T, N_KV_HEADS, GROUP, HEAD_DIM) * (HEAD_DIM ** -0.5)
    qi = jnp.arange(T)[:, None]
    kj = jnp.arange(wb + T)[None, :]
    dist = qi + wb - kj
    mask = (dist >= 0) & (dist < WINDOW)
    bias = rel_bias_from_dist(dist, rel_bias)
    s = jnp.einsum('bqhgd,bkhd->bhgqk', qf, kc.astype(jnp.float32)) + bias[None]
    s = jnp.where(mask[None, None, None], s, NEG_INF)
    p = softmax_with_sink(s, sinks)
    o = jnp.einsum('bhgqk,bkhd->bqhgd', p, vc.astype(jnp.float32))
    return o.reshape(B, T, D_ATT), kc[:, T:], vc[:, T:]


def causal_conv(x, conv_state, w, b):
    T = x.shape[1]
    xp = jnp.concatenate([conv_state.astype(x.dtype), x], axis=1)
    y = b.astype(x.dtype) + w[0].astype(x.dtype) * xp[:, 0:T]
    for tap in range(1, CONV_W):
        y = y + w[tap].astype(x.dtype) * xp[:, tap:tap + T]
    return y, xp[:, T:]


def rg_lru(x, h0, w_a, b_a, w_x, b_x, lam):
    B, T, _ = x.shape
    xf = x.astype(jnp.float32)
    xb = xf.reshape(B, T, N_RNN_BLOCKS, RNN_BLOCK)
    r = jax.nn.sigmoid(jnp.einsum('btni,nij->btnj', xb, w_a.astype(jnp.float32)).reshape(B, T, D_RNN)
                       + b_a.astype(jnp.float32))
    i = jax.nn.sigmoid(jnp.einsum('btni,nij->btnj', xb, w_x.astype(jnp.float32)).reshape(B, T, D_RNN)
                       + b_x.astype(jnp.float32))
    log_a = -LRU_C * r * jax.nn.softplus(-lam.astype(jnp.float32))
    a = jnp.exp(log_a)
    bx = jnp.sqrt(-jnp.expm1(2.0 * log_a)) * (i * xf)

    def combine(left, right):
        a1, b1 = left
        a2, b2 = right
        return a1 * a2, a2 * b1 + b2

    a_cum, b_cum = lax.associative_scan(combine, (a, bx), axis=1)
    h = a_cum * h0.astype(jnp.float32)[:, None] + b_cum
    return h, h[:, -1]


def decoder_layer(x, conv_state, h0, k_buf, v_buf, win_buf, rel_bias,
                  norm_pre, norm_post, w_in, conv_w, conv_b, w_gate_a, b_gate_a,
                  w_gate_x, b_gate_x, lru_lambda, attn_sinks, w_out):
    B, T, _ = x.shape
    xn = rms_norm(x, norm_pre)
    proj = jnp.einsum('btd,de->bte', xn, w_in.astype(xn.dtype))
    x_rnn, g_rnn, q, k, v, g_att = jnp.split(proj, SPLITS, axis=-1)
    xc, new_conv = causal_conv(x_rnn, conv_state, conv_w, conv_b)
    h, h_last = rg_lru(xc, h0, w_gate_a, b_gate_a, w_gate_x, b_gate_x, lru_lambda)
    rnn_out = h * jax.nn.silu(g_rnn.astype(jnp.float32))
    q = q.reshape(B, T, N_HEADS, HEAD_DIM)
    k = k.reshape(B, T, N_KV_HEADS, HEAD_DIM)
    v = v.reshape(B, T, N_KV_HEADS, HEAD_DIM)
    if k_buf is None:
        att = window_attention_prompt(q, k, v, attn_sinks, rel_bias)
        new_k, new_v = k[:, T - win_buf:], v[:, T - win_buf:]
    else:
        att, new_k, new_v = window_attention_sample(q, k, v, k_buf, v_buf, attn_sinks, rel_bias)
    att_out = att * jax.nn.silu(g_att.astype(jnp.float32))
    mix = jnp.concatenate([rnn_out, att_out], axis=-1).astype(x.dtype)
    out = jnp.einsum('bte,ed->btd', mix, w_out.astype(x.dtype))
    y = x + rms_norm(out, norm_post)
    return y, new_conv, h_last, new_k, new_v


def setup_inputs(seed: int = 0) -> dict:
    key = jax.random.key(seed)
    ks = jax.random.split(key, 20)
    win_buf = min(WINDOW, PAST_LEN)
    nrm = jax.random.normal
    x_prompt = nrm(ks[0], (BATCH, SEQ, D_MODEL), jnp.float32)
    x_sample = nrm(ks[1], (DEC_BATCH, DEC_SEQ, D_MODEL), jnp.float32)
    state_conv = nrm(ks[2], (DEPTH, DEC_BATCH, CONV_W - 1, D_RNN), jnp.float32)
    state_rnn = 0.5 * nrm(ks[3], (DEPTH, DEC_BATCH, D_RNN), jnp.float32)
    cache_k_win = nrm(ks[4], (DEPTH, DEC_BATCH, win_buf, N_KV_HEADS, HEAD_DIM), jnp.float32)
    cache_v_win = nrm(ks[5], (DEPTH, DEC_BATCH, win_buf, N_KV_HEADS, HEAD_DIM), jnp.float32)
    norm_pre = 1.0 + 0.05 * nrm(ks[6], (DEPTH, D_MODEL), jnp.float32)
    norm_post = 1.0 + 0.05 * nrm(ks[7], (DEPTH, D_MODEL), jnp.float32)
    w_in = nrm(ks[8], (DEPTH, D_MODEL, D_IN), jnp.float32) * D_MODEL ** -0.5
    conv_w = nrm(ks[9], (DEPTH, CONV_W, D_RNN), jnp.float32) * CONV_W ** -0.5
    conv_b = 0.01 * nrm(ks[10], (DEPTH, D_RNN), jnp.float32)
    w_gate_a = nrm(ks[11], (DEPTH, N_RNN_BLOCKS, RNN_BLOCK, RNN_BLOCK), jnp.float32) * RNN_BLOCK ** -0.5
    b_gate_a = 0.01 * nrm(ks[12], (DEPTH, D_RNN), jnp.float32)
    w_gate_x = nrm(ks[13], (DEPTH, N_RNN_BLOCKS, RNN_BLOCK, RNN_BLOCK), jnp.float32) * RNN_BLOCK ** -0.5
    b_gate_x = 0.01 * nrm(ks[14], (DEPTH, D_RNN), jnp.float32)
    a0 = jax.random.uniform(ks[15], (DEPTH, D_RNN), jnp.float32, minval=0.9, maxval=0.999)
    s = a0 ** (1.0 / LRU_C)
    lru_lambda = jnp.log(s) - jnp.log1p(-s)
    attn_sinks = 0.5 * nrm(ks[16], (DEPTH, N_HEADS), jnp.float32)
    rel_bias = 0.1 * nrm(ks[17], (N_BUCKETS, N_HEADS), jnp.float32)
    w_out = nrm(ks[18], (DEPTH, D_MIX, D_MODEL), jnp.float32) * D_MIX ** -0.5
    return {'x_prompt': x_prompt, 'x_sample': x_sample, 'state_conv': state_conv, 'state_rnn': state_rnn,
            'cache_k_win': cache_k_win, 'cache_v_win': cache_v_win,
            'norm_pre': norm_pre, 'norm_post': norm_post, 'w_in': w_in, 'conv_w': conv_w, 'conv_b': conv_b,
            'w_gate_a': w_gate_a, 'b_gate_a': b_gate_a, 'w_gate_x': w_gate_x, 'b_gate_x': b_gate_x,
            'lru_lambda': lru_lambda, 'attn_sinks': attn_sinks, 'rel_bias': rel_bias, 'w_out': w_out}


def reference(x_prompt, x_sample, state_conv, state_rnn, cache_k_win, cache_v_win,
              norm_pre, norm_post, w_in, conv_w, conv_b, w_gate_a, b_gate_a, w_gate_x, b_gate_x,
              lru_lambda, attn_sinks, rel_bias, w_out):
    win_buf = cache_k_win.shape[2]
    y_prompt, y_sample = x_prompt, x_sample
    conv_p, rnn_p, kw_p, vw_p = [], [], [], []
    conv_s, rnn_s, kw_s, vw_s = [], [], [], []
    for l in range(DEPTH):
        lw = (norm_pre[l], norm_post[l], w_in[l], conv_w[l], conv_b[l], w_gate_a[l], b_gate_a[l],
              w_gate_x[l], b_gate_x[l], lru_lambda[l], attn_sinks[l], w_out[l])
        zc = jnp.zeros((y_prompt.shape[0], CONV_W - 1, D_RNN), y_prompt.dtype)
        zh = jnp.zeros((y_prompt.shape[0], D_RNN), jnp.float32)
        y_prompt, c, h, kw, vw = decoder_layer(y_prompt, zc, zh, None, None, win_buf, rel_bias, *lw)
        conv_p.append(c)
        rnn_p.append(h)
        kw_p.append(kw)
        vw_p.append(vw)
        y_sample, c, h, kw, vw = decoder_layer(y_sample, state_conv[l], state_rnn[l], cache_k_win[l],
                                               cache_v_win[l], win_buf, rel_bias, *lw)
        conv_s.append(c)
        rnn_s.append(h)
        kw_s.append(kw)
        vw_s.append(vw)
    new_conv_prompt = jnp.stack(conv_p)
    new_rnn_prompt = jnp.stack(rnn_p)
    new_k_win_prompt = jnp.stack(kw_p)
    new_v_win_prompt = jnp.stack(vw_p)
    new_conv_sample = jnp.stack(conv_s)
    new_rnn_sample = jnp.stack(rnn_s)
    new_k_win_sample = jnp.stack(kw_s)
    new_v_win_sample = jnp.stack(vw_s)
    return (y_prompt, y_sample, new_conv_prompt, new_rnn_prompt, new_k_win_prompt, new_v_win_prompt,
            new_conv_sample, new_rnn_sample, new_k_win_sample, new_v_win_sample)
```

```cpp
#include <hip/hip_runtime.h>
#include <cstdint>
#include <cstdio>

namespace pg8 {
__device__ __forceinline__ unsigned cvt_pk_bf16(float lo, float hi) { unsigned r; asm volatile("v_cvt_pk_bf16_f32 %0, %1, %2" : "=v"(r) : "v"(lo), "v"(hi)); return r; }
}

typedef unsigned short bf16;
#define LAS __attribute__((address_space(3)))
#define GAS __attribute__((address_space(1)))
typedef unsigned v4u __attribute__((ext_vector_type(4)));
typedef unsigned v2u __attribute__((ext_vector_type(2)));
typedef float f32x4 __attribute__((ext_vector_type(4)));
typedef short bf16x8 __attribute__((ext_vector_type(8)));
constexpr int DM = 1024, BATCH = 2, SEQ = 8192, DECB = 128;
constexpr int DRNN = 512, DATT = 512, NH = 8, HD = 64, NKV = 2, KVD = 128, WIN = 128, NBUCK = 32;
constexpr int DIN = 2304;
constexpr int MP = BATCH * SEQ;
constexpr int MT = MP + DECB;
constexpr int MPAD = 16640;
constexpr int NCHUNK = SEQ / 64;
constexpr float EPS = 1e-6f;
constexpr float LOG2E = 1.4426950408889634f;
constexpr float QSCALE = 0.125f * LOG2E;

constexpr size_t O_YP = 0, O_YS = O_YP + (size_t)MP * DM, O_CP = O_YS + (size_t)DECB * DM, O_RP = O_CP + 2 * 3 * 512, O_KP = O_RP + 2 * 512,
                 O_VP = O_KP + 2 * 128 * 128, O_CS = O_VP + 2 * 128 * 128, O_RS = O_CS + (size_t)DECB * 3 * 512, O_KS = O_RS + (size_t)DECB * 512,
                 O_VS = O_KS + (size_t)DECB * 128 * 128, O_END = O_VS + (size_t)DECB * 128 * 128;

constexpr size_t MiB = 1u << 20;
constexpr size_t WS_CTL = 0, CTL_ZERO_BYTES = 32768;
constexpr size_t WS_WA = 1 * MiB;
constexpr size_t WS_WB = 3 * MiB;
constexpr size_t WS_WOUT = 6 * MiB;
constexpr size_t WS_WG = 8 * MiB;
constexpr size_t WS_WKV = 8 * MiB + 128 * 1024;
constexpr size_t WS_RSTD = 8 * MiB + 768 * 1024;
constexpr size_t WS_AGG = 9 * MiB;
constexpr size_t WS_XB = 10 * MiB;
constexpr size_t WS_XR = 43 * MiB;
constexpr size_t WS_SGR = 60 * MiB;
constexpr size_t WS_Q = 77 * MiB;
constexpr size_t WS_SGA = 94 * MiB;
constexpr size_t WS_KV = 111 * MiB;
constexpr size_t WS_MIX = 120 * MiB;
constexpr size_t WS_OUTS = 153 * MiB;
constexpr size_t WS_XB2 = 154 * MiB;
constexpr size_t WS_END = 186 * MiB;
constexpr int CW_SMP = 512;
constexpr int CW_AGG = 576;
constexpr int CW_OUTS = 640;
constexpr int CW_BAR = 1024;

constexpr int RING_BYTES = 131072, LDSCTL_OFF = 153600, MISC_OFF = LDSCTL_OFF + 320, LDS_BYTES = 155648;
constexpr int A_STRIDE = 1040;
constexpr int A_ATT = 0, A_RNN = 66560, A_PART = 133120, A_HIN = 135168;
static_assert(A_RNN + 64 * A_STRIDE <= A_PART && A_HIN + 2048 <= LDSCTL_OFF, "lds map");

#define LDS_WAIT() asm volatile("s_waitcnt lgkmcnt(0)" ::: "memory")
#define ST_WT128(ptr, val) asm volatile("global_store_dwordx4 %0, %1, off sc0 sc1\n\ts_nop 1" :: "v"(ptr), "v"(val) : "memory")
#define VM_WAIT() asm volatile("s_waitcnt vmcnt(0)" ::: "memory")
__device__ __forceinline__ float bf2f(bf16 v) { return __uint_as_float((unsigned)v << 16); }
__device__ __forceinline__ unsigned f2bf(float f) { unsigned u = __float_as_uint(f); return (u + 0x7fffu + ((u >> 16) & 1u)) >> 16; }
__device__ __forceinline__ unsigned pk2(float lo, float hi) { return f2bf(lo) | (f2bf(hi) << 16); }
__device__ __forceinline__ float ex2(float x) { return __builtin_amdgcn_exp2f(x); }
__device__ __forceinline__ float rcpf_(float x) { return __builtin_amdgcn_rcpf(x); }
__device__ __forceinline__ float sigmoid_(float x) { return rcpf_(1.0f + ex2(-LOG2E * x)); }
__device__ __forceinline__ float silu_(float x) { return x * sigmoid_(x); }
__device__ __forceinline__ int t5_bucket(int dist) {
    if (dist < 0) dist = 0;
    if (dist < 16) return dist;
    const float d = (float)dist;
    int large = 16 + (int)(logf(d / 16.0f) / 2.0794415416798357f * 16.0f);
    return large < 31 ? large : 31;
}
__device__ __forceinline__ float softplus_neg(float l) { return (l > 0.f) ? log1pf(__expf(-l)) : (-l + log1pf(__expf(l))); }
__device__ __forceinline__ float wave_sum(float v) {
#pragma unroll
    for (int o = 1; o < 64; o <<= 1) v += __shfl_xor(v, o);
    return v;
}


#define XB_TMO      128
#define XB_XCNT(j)  (256  + 64 * (j))
#define XB_XSUB(j)  (1280 + 64 * (j))
#define XB_XGEN(j)  (2304 + 64 * (j))
#define XB_TOP      3328
#define XB_TOPGEN   3392
#define XCD_BAR_WORDS 3456
#define XB_SPIN_CAP (1u << 18)
__device__ __forceinline__ unsigned xb_ld(unsigned* p)              { return __hip_atomic_load(p, __ATOMIC_RELAXED, __HIP_MEMORY_SCOPE_AGENT); }
__device__ __forceinline__ unsigned xb_add(unsigned* p, unsigned v) { return __hip_atomic_fetch_add(p, v, __ATOMIC_RELAXED, __HIP_MEMORY_SCOPE_AGENT); }
__device__ __forceinline__ unsigned xb_xcc_id() { return (unsigned)__builtin_amdgcn_s_getreg((3 << 11) | 20) & 0xFu; }
#define XB_SPIN(cond, bar) do { unsigned _sp = 0; while (cond) { __builtin_amdgcn_s_sleep(1); \
    if ((++_sp & 255u) == 0u) { if (xb_ld(&(bar)[XB_TMO])) break; if (_sp > XB_SPIN_CAP) { atomicAdd(&(bar)[XB_TMO], 1u); break; } } } } while (0)
struct XcdBarrier { unsigned* bar; unsigned x; volatile LAS unsigned* st; };
__device__ __forceinline__ XcdBarrier xcd_barrier_post(unsigned* bar, volatile LAS unsigned* st) {
    XcdBarrier b; b.bar = bar; b.x = xb_xcc_id(); b.st = st;
    if (threadIdx.x == 0) (void)xb_add(&bar[XB_XCNT(b.x)], 1u);
    return b;
}
__device__ __forceinline__ void xcd_barrier_complete(unsigned* bar, unsigned x, unsigned& nloc, unsigned& nx) {
    const unsigned G = gridDim.x * gridDim.y * gridDim.z;
    unsigned sum, cnt, mine, sp = 0u;
    for (;;) {
        sum = 0u; cnt = 0u; mine = 0u;
#pragma unroll
        for (unsigned j = 0; j < 16; ++j) { const unsigned c = xb_ld(&bar[XB_XCNT(j)]); sum += c; cnt += (c > 0u) ? 1u : 0u; mine = (j == x) ? c : mine; }
        if (sum == G) break;
        __builtin_amdgcn_s_sleep(1);
        if ((++sp & 255u) == 0u) { if (xb_ld(&bar[XB_TMO])) break; if (sp > XB_SPIN_CAP) { atomicAdd(&bar[XB_TMO], 1u); break; } }
    }
    nloc = mine > 0u ? mine : 1u; nx = cnt > 0u ? cnt : 1u;
}
__device__ __forceinline__ void xcd_barrier(const XcdBarrier& b) {
    asm volatile("s_waitcnt vmcnt(0)" ::: "memory");
    __syncthreads();
    if (threadIdx.x == 0) {
        unsigned* bar = b.bar;
        __builtin_amdgcn_s_waitcnt(0);
        unsigned nloc = b.st[0], nx = b.st[1];
        if (nloc == 0u) { xcd_barrier_complete(bar, b.x, nloc, nx); b.st[0] = nloc; b.st[1] = nx; }
        const unsigned old = xb_add(&bar[XB_XSUB(b.x)], 1u);
        const unsigned gen = old / nloc;
        if (old + 1u == (gen + 1u) * nloc) {
            __builtin_amdgcn_fence(__ATOMIC_RELEASE, "agent");
            asm volatile("s_waitcnt vmcnt(0)" ::: "memory");
            const unsigned og = xb_add(&bar[XB_TOP], 1u);
            const unsigned tg = og / nx;
            if (og + 1u == (tg + 1u) * nx) xb_add(&bar[XB_TOPGEN], 1u);
            else XB_SPIN(xb_ld(&bar[XB_TOPGEN]) == tg, bar);
            __builtin_amdgcn_fence(__ATOMIC_ACQUIRE, "agent");
            xb_add(&bar[XB_XGEN(b.x)], 1u);
            asm volatile("s_waitcnt vmcnt(0)" ::: "memory");
        } else {
            __builtin_amdgcn_fence(__ATOMIC_ACQUIRE, "agent");
            asm volatile("s_waitcnt vmcnt(0)" ::: "memory");
            XB_SPIN(xb_ld(&bar[XB_XGEN(b.x)]) == gen, bar);
        }
    }
    __syncthreads();
}

template <int MODE>
__device__ __forceinline__ void p0_transpose_item(const float* W, int K, int N, bf16* WT, const float* kscale, LAS float* scr, int item, int lane, int dst_n0, float gscale = 1.0f) {
    const int nblk = N / 32, kb = item / nblk, nb = item % nblk, k0 = 64 * kb, n0 = 32 * nb;
    {   float wv[32], sv[32];
#pragma unroll
        for (int i = 0; i < 32; ++i) { const int kk = 2 * i + (lane >> 5); wv[i] = __builtin_nontemporal_load(W + (size_t)(k0 + kk) * N + n0 + (lane & 31)); sv[i] = kscale ? kscale[k0 + kk] : 1.0f; }
        __builtin_amdgcn_sched_barrier(0);
#pragma unroll
        for (int i = 0; i < 32; ++i) { const int kk = 2 * i + (lane >> 5); scr[kk * 33 + (lane & 31)] = wv[i] * sv[i] * gscale; }
    }
    LDS_WAIT(); asm volatile("" ::: "memory");
    const int c = lane & 7;
#pragma unroll
    for (int j = 0; j < 4; ++j) { const int n = (lane >> 3) + 8 * j; const LAS float* sp = scr + (8 * c) * 33 + n;
        v4u o; o.x = pk2(sp[0 * 33], sp[1 * 33]); o.y = pk2(sp[2 * 33], sp[3 * 33]); o.z = pk2(sp[4 * 33], sp[5 * 33]); o.w = pk2(sp[6 * 33], sp[7 * 33]);
        const int nn = dst_n0 + n, kk = k0 + 8 * c;
        if (MODE == 3 || MODE == 4) {
            const int NTT = MODE == 3 ? 8 : 2, slab = MODE == 3 ? nn >> 7 : nn >> 5, cw = MODE == 3 ? nn & 127 : nn & 31, rem = cw & 31;
            const int nt = 2 * (cw >> 5) + ((rem >> 2) & 1), ln = 4 * (rem >> 3) + (rem & 3);
            { bf16* wp_ = WT + ((size_t)(((slab * 32 + (kk >> 5)) * NTT + nt) * 64 + (((kk >> 3) & 3) * 16 + ln))) * 8; ST_WT128(wp_, o); } }
        else if (MODE == 1) { bf16* wp_ = WT + ((size_t)((((nn >> 7) * 32 + (kk >> 5)) * 8 + ((nn >> 4) & 7)) * 64 + (((kk >> 3) & 3) * 16 + (nn & 15)))) * 8; ST_WT128(wp_, o); }
        else if (MODE == 2) *(v4u*)(WT + ((size_t)((((nn >> 5) * 32 + (kk >> 5)) * 2 + ((nn >> 4) & 1)) * 64 + (((kk >> 3) & 3) * 16 + (nn & 15)))) * 8) = o;
        else { bf16* wp_ = WT + (size_t)nn * K + kk; ST_WT128(wp_, o); } }
    LDS_WAIT(); asm volatile("" ::: "memory");
}
template <int NR>
__device__ __forceinline__ void p0_rows(const float* const (&xrow)[NR], bf16* const (&orow)[NR], float* const (&rs)[NR], int lane) {
    f32x4 v[NR][4];
#pragma unroll
    for (int r = 0; r < NR; ++r)
#pragma unroll
        for (int j = 0; j < 4; ++j) v[r][j] = ((const f32x4*)xrow[r])[lane + 64 * j];
    __builtin_amdgcn_sched_barrier(0);
#pragma unroll
    for (int r = 0; r < NR; ++r) { float s = 0.f;
#pragma unroll
        for (int j = 0; j < 4; ++j) s += (v[r][j].x * v[r][j].x + v[r][j].y * v[r][j].y) + (v[r][j].z * v[r][j].z + v[r][j].w * v[r][j].w);
        s = wave_sum(s);
        if (lane == 0) __hip_atomic_store(rs[r], rsqrtf(s * (1.0f / DM) + EPS), __ATOMIC_RELAXED, __HIP_MEMORY_SCOPE_AGENT);
        unsigned long long* o8 = (unsigned long long*)orow[r] + lane;
#pragma unroll
        for (int j = 0; j < 4; ++j) __hip_atomic_store(o8 + 64 * j, (unsigned long long)pk2(v[r][j].x, v[r][j].y) | ((unsigned long long)pk2(v[r][j].z, v[r][j].w) << 32), __ATOMIC_RELAXED, __HIP_MEMORY_SCOPE_AGENT); }
}

typedef _Float16 f16;
struct RgArgs { const bf16* XR; const bf16* SGR; const bf16* WG; const float* conv_w; const float* conv_b; const float* b_a; const float* b_x; const float* lam; float* AGG; unsigned* UV; };
constexpr int XCB_STRIDE = 1040;
constexpr int ZS = 516;
constexpr int RG_XCB = 0, RG_ZR = 16 * XCB_STRIDE, RG_ZI = RG_ZR + 16 * ZS * 4, RG_LDS = RG_ZI + 16 * ZS * 4;
static_assert(RG_LDS <= 100 * 1024, "rg lds");
__device__ __forceinline__ void rglru_unit(LAS unsigned char* lds, const RgArgs& R, int b, int c) {
    int tid = threadIdx.x; asm volatile("" : "+v"(tid));
    const int ch = tid, lane = tid & 63, w = __builtin_amdgcn_readfirstlane(tid >> 6);
    const size_t row0 = (size_t)b * SEQ + 64 * c;
    bf16x8 bw[2][4][2];
#pragma unroll
    for (int g = 0; g < 2; ++g)
#pragma unroll
        for (int nt = 0; nt < 4; ++nt)
#pragma unroll
            for (int ks = 0; ks < 2; ++ks) bw[g][nt][ks] = *(const bf16x8*)(R.WG + ((size_t)((w * 2 + g) * 64 + nt * 16 + (lane & 15))) * 64 + ks * 32 + 8 * (lane >> 4));
    const float cb = R.conv_b[ch], w0 = R.conv_w[ch], w1 = R.conv_w[512 + ch], w2 = R.conv_w[1024 + ch], w3 = R.conv_w[1536 + ch];
    const float ba = -LOG2E * R.b_a[ch], bxb = -LOG2E * R.b_x[ch];
    const float c2 = -8.0f * softplus_neg(R.lam[ch]) * LOG2E;
    float h = 0.f, acum = 1.0f;
    const bf16* xp = R.XR + row0 * 512 + ch;
    float xm3 = 0.f, xm2 = 0.f, xm1 = 0.f;
    if (c > 0) { xm3 = bf2f(xp[-3 * 512]); xm2 = bf2f(xp[-2 * 512]); xm1 = bf2f(xp[-1 * 512]); }
    unsigned xs[16], sg[16];
    const bf16* sp = R.SGR + row0 * 512 + ch;
#pragma unroll
    for (int i = 0; i < 16; ++i) { xs[i] = xp[i * 512]; sg[i] = sp[i * 512]; }
    __builtin_amdgcn_sched_barrier(0);
    LAS unsigned char* xcb = lds + RG_XCB; LAS float* zr = (LAS float*)(lds + RG_ZR); LAS float* zi = (LAS float*)(lds + RG_ZI);
    unsigned* uvp = R.UV + row0 * 512 + ch;
#pragma unroll 1
    for (int s = 0; s < 4; ++s) {
        unsigned xn[16], sn[16];
        { const int s1 = s < 3 ? s + 1 : 3;
#pragma unroll
            for (int i = 0; i < 16; ++i) { xn[i] = xp[(16 * s1 + i) * 512]; sn[i] = sp[(16 * s1 + i) * 512]; } }
        float xc[16];
#pragma unroll
        for (int i = 0; i < 16; ++i) { const float x = __uint_as_float(xs[i] << 16); xc[i] = cb + w0 * xm3 + w1 * xm2 + w2 * xm1 + w3 * x; xm3 = xm2; xm2 = xm1; xm1 = x;
            *(LAS bf16*)(xcb + i * XCB_STRIDE + ch * 2) = (bf16)pg8::cvt_pk_bf16(xc[i], 0.f); }
        LDS_WAIT(); __builtin_amdgcn_wave_barrier();
        {
            bf16x8 af[2];
#pragma unroll
            for (int ks = 0; ks < 2; ++ks) af[ks] = *(const LAS bf16x8*)(xcb + (lane & 15) * XCB_STRIDE + (64 * w + 32 * ks + 8 * (lane >> 4)) * 2);
#pragma unroll
            for (int g = 0; g < 2; ++g)
#pragma unroll
                for (int nt = 0; nt < 4; ++nt) { f32x4 acc = {0.f, 0.f, 0.f, 0.f};
#pragma unroll
                    for (int ks = 0; ks < 2; ++ks) acc = __builtin_amdgcn_mfma_f32_16x16x32_bf16(af[ks], bw[g][nt][ks], acc, 0, 0, 0);
                    LAS float* z = g ? zi : zr;
#pragma unroll
                    for (int r = 0; r < 4; ++r) z[(4 * (lane >> 4) + r) * ZS + 64 * w + 16 * nt + (lane & 15)] = acc[r]; }
        }
        LDS_WAIT(); __builtin_amdgcn_wave_barrier();
        typedef float f32x2 __attribute__((ext_vector_type(2)));
#pragma unroll
        for (int i = 0; i < 16; i += 2) {
            const f32x2 zrv = {zr[i * ZS + ch], zr[(i + 1) * ZS + ch]}, ziv = {zi[i * ZS + ch], zi[(i + 1) * ZS + ch]};
            const f32x2 er = zrv + ba, ei = ziv + bxb;
            f32x2 dr = {ex2(er.x), ex2(er.y)}, di = {ex2(ei.x), ex2(ei.y)};
            dr = dr + 1.0f; di = di + 1.0f;
            const f32x2 r = {rcpf_(dr.x), rcpf_(dr.y)}, ig = {rcpf_(di.x), rcpf_(di.y)};
            const f32x2 l2 = r * c2;
            const f32x2 a = {ex2(l2.x), ex2(l2.y)};
            const f32x2 x2 = l2 * 1.3862943611198906f;
            const f32x2 em_small = -x2 * ((x2 * 0.16666667f + 0.5f) * x2 + 1.0f);
            const f32x2 em_big = 1.0f - a * a;
            const f32x2 em = {(x2.x > -0.015625f) ? em_small.x : em_big.x, (x2.y > -0.015625f) ? em_small.y : em_big.y};
            const f32x2 sq = {__builtin_amdgcn_sqrtf(em.x), __builtin_amdgcn_sqrtf(em.y)};
            const f32x2 xcv = {xc[i], xc[i + 1]};
            const f32x2 bx = sq * (ig * xcv);
            const float h0 = __builtin_fmaf(a.x, h, bx.x), h1 = __builtin_fmaf(a.y, h0, bx.y);
            const float ac0 = acum * a.x, ac1 = ac0 * a.y;
            h = h1; acum = ac1;
            const f32x2 sgv = {__uint_as_float(sg[i] << 16), __uint_as_float(sg[i + 1] << 16)};
            const f32x2 uu = sgv * (f32x2){h0, h1}, vv2 = sgv * (f32x2){ac0, ac1};
            typedef f16 f16x2 __attribute__((ext_vector_type(2)));
            const f16x2 p0 = {(f16)uu.x, (f16)vv2.x}, p1 = {(f16)uu.y, (f16)vv2.y};
            uvp[(size_t)(16 * s + i) * 512] = __builtin_bit_cast(unsigned, p0);
            uvp[(size_t)(16 * s + i + 1) * 512] = __builtin_bit_cast(unsigned, p1);
        }
#pragma unroll
        for (int i = 0; i < 16; ++i) { xs[i] = xn[i]; sg[i] = sn[i]; }
    }
    { float* ag = R.AGG + ((size_t)b * NCHUNK + c) * 1024 + ch;
      __hip_atomic_store(ag, acum, __ATOMIC_RELAXED, __HIP_MEMORY_SCOPE_AGENT); __hip_atomic_store(ag + 512, h, __ATOMIC_RELAXED, __HIP_MEMORY_SCOPE_AGENT); }
    VM_WAIT(); __syncthreads();
}

typedef float f32x16 __attribute__((ext_vector_type(16)));
constexpr int AT_K = 0, AT_KS = 144, AT_NK = 192, AT_VT = 2 * AT_NK * AT_KS, AT_VS = 392, AT_T = AT_VT + 2 * 64 * AT_VS, AT_LDS = AT_T + 8 * 384 * 4;
static_assert(AT_LDS <= 144384, "attention lds");
__device__ __forceinline__ unsigned cvtpk(float lo, float hi) { unsigned r; asm volatile("v_cvt_pk_bf16_f32 %0, %1, %2" : "=v"(r) : "v"(lo), "v"(hi)); return r; }
__device__ __forceinline__ void attn_table(LAS unsigned char* lds, const float* rel_bias) {
    LAS float* T = (LAS float*)(lds + AT_T);
    for (int e = threadIdx.x; e < 8 * 384; e += 512) { const int hl = e / 384, ti = e - hl * 384; float v = -1e30f; if (ti >= 128 && ti <= 255) v = rel_bias[t5_bucket(255 - ti) * NH + hl] * LOG2E; T[e] = v; }
}
__device__ __forceinline__ void attn_unit(LAS unsigned char* lds, int b, int c, const bf16* Q, const bf16* KV, const bf16* SGA, const float* sinks, const float* rel_bias, bf16* MIX, bool build_T) {
    int tid = threadIdx.x; asm volatile("" : "+v"(tid));
    const int lane = tid & 63, w = __builtin_amdgcn_readfirstlane(tid >> 6), r32 = lane & 31, hi = lane >> 5;
    const int n = c >> 1, half = c & 1, kt0 = 2 * half, h = w, g = w >> 2;
    const size_t rowblk = (size_t)b * SEQ + 128 * n;
    LAS float* T = (LAS float*)(lds + AT_T);
    {   v4u kk[6], vv[6];
#pragma unroll
        for (int i = 0; i < 6; ++i) { const int e = tid + 512 * i, key = e >> 4, gq = (e >> 3) & 1, cc = e & 7;
            const int kb = 32 * kt0 + key;
            const int ksrc = (n > 0 || kb >= 128) ? kb : kb + 128;
            const bf16* kr = KV + (rowblk - 128 + ksrc) * 256 + gq * 64 + cc * 8;
            kk[i] = *(const v4u*)kr; vv[i] = *(const v4u*)(kr + 128); }
        __builtin_amdgcn_sched_barrier(0);
#pragma unroll
        for (int i = 0; i < 6; ++i) { const int e = tid + 512 * i, key = e >> 4, gq = (e >> 3) & 1, cc = e & 7;
            *(LAS v4u*)(lds + AT_K + (gq * AT_NK + key) * AT_KS + cc * 16) = kk[i];
#pragma unroll
            for (int j = 0; j < 8; ++j) *(LAS bf16*)(lds + AT_VT + (gq * 64 + cc * 8 + j) * AT_VS + key * 2) = (bf16)((vv[i][j >> 1] >> (16 * (j & 1))) & 0xffffu); }
    }
    if (build_T) attn_table(lds, rel_bias);
    LDS_WAIT(); __syncthreads();
    const float sinkv = sinks[h] * LOG2E;
#pragma unroll 1
    for (int i = 0; i < 2; ++i) {
        const int qt = kt0 + i; const size_t qrow = rowblk + 32 * qt + r32;
        bf16x8 qf[4];
#pragma unroll
        for (int ks = 0; ks < 4; ++ks) qf[ks] = *(const bf16x8*)(Q + qrow * 512 + h * 64 + 16 * ks + 8 * hi);
        v2u sgv[2][4];
#pragma unroll
        for (int dt = 0; dt < 2; ++dt)
#pragma unroll
            for (int i4 = 0; i4 < 4; ++i4) sgv[dt][i4] = *(const v2u*)(SGA + qrow * 512 + h * 64 + 32 * dt + 8 * i4 + 4 * hi);
        f32x16 s[5];
#pragma unroll
        for (int j = 0; j < 5; ++j) {
            const int kt = qt + j, ktl = i + j;
            if (n == 0 && kt < 4) {
#pragma unroll
                for (int r = 0; r < 16; ++r) s[j][r] = -1e30f;
            } else {
                const LAS float* tp = T + h * 384 + (32 * kt + 4 * hi - 32 * qt - r32 + 127);
#pragma unroll
                for (int r = 0; r < 16; ++r) s[j][r] = tp[(r & 3) + 8 * (r >> 2)];
                const LAS unsigned char* kp = lds + AT_K + (g * AT_NK + 32 * ktl + r32) * AT_KS + 16 * hi;
#pragma unroll
                for (int ks = 0; ks < 4; ++ks) { const bf16x8 kf = *(const LAS bf16x8*)(kp + 32 * ks); s[j] = __builtin_amdgcn_mfma_f32_32x32x16_bf16(kf, qf[ks], s[j], 0, 0, 0); }
            }
        }
        float m = sinkv;
#pragma unroll
        for (int j = 0; j < 5; ++j)
#pragma unroll
            for (int r = 0; r < 16; ++r) m = fmaxf(m, s[j][r]);
        { auto rr = __builtin_amdgcn_permlane32_swap(__float_as_uint(m), __float_as_uint(m), false, false); m = fmaxf(__uint_as_float(rr[0]), __uint_as_float(rr[1])); }
        float l = 0.f;
#pragma unroll
        for (int j = 0; j < 5; ++j)
#pragma unroll
            for (int r = 0; r < 16; ++r) { const float p = ex2(s[j][r] - m); s[j][r] = p; l += p; }
        { auto rr = __builtin_amdgcn_permlane32_swap(__float_as_uint(l), __float_as_uint(l), false, false); l = __uint_as_float(rr[0]) + __uint_as_float(rr[1]); }
        l += ex2(sinkv - m);
        f32x16 o[2];
#pragma unroll
        for (int r = 0; r < 16; ++r) { o[0][r] = 0.f; o[1][r] = 0.f; }
#pragma unroll
        for (int j = 0; j < 5; ++j) {
            const int kt = qt + j, ktl = i + j;
            if (!(n == 0 && kt < 4)) {
#pragma unroll
                for (int s2 = 0; s2 < 2; ++s2) {
                    v4u pw; pw.x = cvtpk(s[j][8 * s2 + 0], s[j][8 * s2 + 1]); pw.y = cvtpk(s[j][8 * s2 + 2], s[j][8 * s2 + 3]); pw.z = cvtpk(s[j][8 * s2 + 4], s[j][8 * s2 + 5]); pw.w = cvtpk(s[j][8 * s2 + 6], s[j][8 * s2 + 7]);
                    const bf16x8 pf = __builtin_bit_cast(bf16x8, pw);
#pragma unroll
                    for (int dt = 0; dt < 2; ++dt) {
                        const LAS unsigned char* vp = lds + AT_VT + (g * 64 + 32 * dt + r32) * AT_VS + (32 * ktl + 16 * s2 + 4 * hi) * 2;
                        const v2u vlo = *(const LAS v2u*)vp, vhi = *(const LAS v2u*)(vp + 16);
                        v4u vw; vw.x = vlo.x; vw.y = vlo.y; vw.z = vhi.x; vw.w = vhi.y;
                        o[dt] = __builtin_amdgcn_mfma_f32_32x32x16_bf16(__builtin_bit_cast(bf16x8, vw), pf, o[dt], 0, 0, 0);
                    }
                }
            }
        }
        const float il = 1.0f / l;
#pragma unroll
        for (int dt = 0; dt < 2; ++dt)
#pragma unroll
            for (int i4 = 0; i4 < 4; ++i4) { const int d0 = 32 * dt + 8 * i4 + 4 * hi; const v2u sg = sgv[dt][i4];
                const float a0 = o[dt][4 * i4 + 0] * il * __uint_as_float(sg.x << 16), a1 = o[dt][4 * i4 + 1] * il * __uint_as_float(sg.x & 0xffff0000u);
                const float a2 = o[dt][4 * i4 + 2] * il * __uint_as_float(sg.y << 16), a3 = o[dt][4 * i4 + 3] * il * __uint_as_float(sg.y & 0xffff0000u);
                v2u ov; ov.x = cvtpk(a0, a1); ov.y = cvtpk(a2, a3);
                *(v2u*)(MIX + qrow * 512 + h * 64 + d0) = ov; }
    }
    __syncthreads();
}

struct SmpArgs { const bf16 *XR, *SGR, *Q, *KV, *SGA, *WG; const float *state_conv, *state_rnn, *ck, *cv, *conv_w, *conv_b, *b_a, *b_x, *lam, *sinks; bf16* MIX; float* out; };
constexpr int SM_XC = 0, SM_QS = 1024, SM_PS = 2048, SM_XB = 4096, SM_ZS = 4608, SM_KS = 8192, SM_VS = SM_KS + 128 * 65 * 4, SM_LDS = SM_VS + 128 * 64 * 4;
constexpr int BTAB_OFF = 144384;
static_assert(SM_ZS + 2048 <= SM_KS && SM_LDS <= BTAB_OFF && BTAB_OFF + 4096 <= LDSCTL_OFF, "sample lds");
__device__ __forceinline__ void st_wt16(bf16* p, unsigned v) { __hip_atomic_store(p, (bf16)v, __ATOMIC_RELAXED, __HIP_MEMORY_SCOPE_AGENT); }
struct SmpPre { f32x4 kk[4], vv[4]; };
__device__ __forceinline__ void sample_prefetch(SmpPre& p, const float* ck, const float* cv, int b, int g, int tid) {
    const float* ckb = ck + (size_t)b * 16384 + 128 + g * 64; const float* cvb = cv + (size_t)b * 16384 + 128 + g * 64;
#pragma unroll
    for (int i = 0; i < 4; ++i) { const int e0 = tid + 512 * i, e = e0 < 127 * 16 ? e0 : 127 * 16 - 1; const int ww = e >> 4, d = (e & 15) * 4; p.kk[i] = __builtin_nontemporal_load((const f32x4*)(ckb + ww * 128 + d)); p.vv[i] = __builtin_nontemporal_load((const f32x4*)(cvb + ww * 128 + d)); }
}
template <bool PRE>
__device__ __forceinline__ void sample_unit(LAS unsigned char* lds, const LAS float* btab, const SmpArgs& S, int b, int g, unsigned* cnt, const SmpPre& pre) {
    LAS float* xc = (LAS float*)(lds + SM_XC); LAS float* qs = (LAS float*)(lds + SM_QS); LAS float* ps = (LAS float*)(lds + SM_PS); LAS float* Ks = (LAS float*)(lds + SM_KS); LAS float* Vs = (LAS float*)(lds + SM_VS);
    LAS float* zs = (LAS float*)(lds + SM_ZS);
    int tid = threadIdx.x; asm volatile("" : "+v"(tid));
    const int lane = tid & 63, w = __builtin_amdgcn_readfirstlane(tid >> 6);
    const size_t r = (size_t)(MP + b);
    const int t8 = tid & 255, ch = 256 * g + t8;
    const float* ckb = S.ck + (size_t)b * 16384 + 128 + g * 64; const float* cvb = S.cv + (size_t)b * 16384 + 128 + g * 64;
    f32x4 kk[4], vv[4];
    if (PRE) {
#pragma unroll
        for (int i = 0; i < 4; ++i) { kk[i] = pre.kk[i]; vv[i] = pre.vv[i]; }
    } else {
#pragma unroll
        for (int i = 0; i < 4; ++i) { const int e0 = tid + 512 * i, e = e0 < 127 * 16 ? e0 : 127 * 16 - 1; const int ww = e >> 4, d = (e & 15) * 4; kk[i] = __builtin_nontemporal_load((const f32x4*)(ckb + ww * 128 + d)); vv[i] = __builtin_nontemporal_load((const f32x4*)(cvb + ww * 128 + d)); }
    }
    const unsigned x0u = S.XR[r * 512 + ch], qu = S.Q[r * 512 + ch], sgru = S.SGR[r * 512 + ch], sgau = S.SGA[r * 512 + ch];
    const unsigned knu = S.KV[r * 256 + g * 64 + (tid & 63)], vnu = S.KV[r * 256 + 128 + g * 64 + (tid & 63)];
    const float s0 = S.state_conv[(size_t)(b * 3 + 0) * 512 + ch], s1 = S.state_conv[(size_t)(b * 3 + 1) * 512 + ch], s2 = S.state_conv[(size_t)(b * 3 + 2) * 512 + ch];
    const float cw0 = S.conv_w[ch], cw1 = S.conv_w[512 + ch], cw2 = S.conv_w[1024 + ch], cw3 = S.conv_w[1536 + ch], cbv = S.conv_b[ch];
    const float bav = S.b_a[ch], bxv = S.b_x[ch], lamv = S.lam[ch], h0 = S.state_rnn[(size_t)b * 512 + ch];
    const float skv = S.sinks[4 * g + (w & 3)];
    bf16x8 bw[2][4][2];
    { const int nb = 4 * g + (w & 3);
#pragma unroll
      for (int gg = 0; gg < 2; ++gg)
#pragma unroll
        for (int nt = 0; nt < 4; ++nt)
#pragma unroll
            for (int ks = 0; ks < 2; ++ks) bw[gg][nt][ks] = *(const bf16x8*)(S.WG + ((size_t)((nb * 2 + gg) * 64 + nt * 16 + (lane & 15))) * 64 + ks * 32 + 8 * (lane >> 4)); }
    __builtin_amdgcn_sched_barrier(0);
    const float x0 = __uint_as_float(x0u << 16);
    const float xcv = cbv + cw0 * s0 + cw1 * s1 + cw2 * s2 + cw3 * x0;
    if (tid < 256) { xc[t8] = xcv; *(LAS bf16*)(lds + SM_XB + t8 * 2) = (bf16)pg8::cvt_pk_bf16(xcv, 0.f); qs[t8] = __uint_as_float(qu << 16);
        S.out[O_CS + (size_t)(b * 3 + 0) * 512 + ch] = s1; S.out[O_CS + (size_t)(b * 3 + 1) * 512 + ch] = s2; }
    else if (tid < 320) { Ks[127 * 65 + lane] = __uint_as_float(knu << 16); Vs[127 * 64 + lane] = __uint_as_float(vnu << 16); }
#pragma unroll
    for (int i = 0; i < 4; ++i) { const int e = tid + 512 * i; if (e < 127 * 16) { const int ww = e >> 4, d = (e & 15) * 4;
        LAS float* kd = Ks + ww * 65 + d; kd[0] = kk[i].x; kd[1] = kk[i].y; kd[2] = kk[i].z; kd[3] = kk[i].w; *(LAS f32x4*)(Vs + ww * 64 + d) = vv[i]; } }
    __syncthreads();    if (tid < 256) {
        bf16x8 af[2];
#pragma unroll
        for (int ks = 0; ks < 2; ++ks) af[ks] = *(const LAS bf16x8*)(lds + SM_XB + (64 * w + 32 * ks + 8 * (lane >> 4)) * 2);
#pragma unroll
        for (int gg = 0; gg < 2; ++gg)
#pragma unroll
            for (int nt = 0; nt < 4; ++nt) { f32x4 acc = {0.f, 0.f, 0.f, 0.f};
#pragma unroll
                for (int ks = 0; ks < 2; ++ks) acc = __builtin_amdgcn_mfma_f32_16x16x32_bf16(af[ks], bw[gg][nt][ks], acc, 0, 0, 0);
                if (lane < 16) zs[gg * 256 + 64 * w + 16 * nt + lane] = acc[0]; }
        LDS_WAIT(); __builtin_amdgcn_wave_barrier();
        const float rr = rcpf_(1.0f + ex2(zs[t8] - LOG2E * bav)), ig = rcpf_(1.0f + ex2(zs[256 + t8] - LOG2E * bxv));
        const float l2 = rr * (-8.0f * softplus_neg(lamv) * LOG2E); const float a = ex2(l2);
        const float x2 = 1.3862943611198906f * l2;
        const float em_small = -x2 * __builtin_fmaf(__builtin_fmaf(x2, 0.16666667f, 0.5f), x2, 1.0f);
        const float em = (x2 > -0.015625f) ? em_small : __builtin_fmaf(-a, a, 1.0f);
        const float h = a * h0 + __builtin_amdgcn_sqrtf(em) * (ig * xcv);
        S.out[O_RS + (size_t)b * 512 + ch] = h;
        st_wt16(S.MIX + r * DM + ch, pg8::cvt_pk_bf16(h * __uint_as_float(sgru << 16), 0.f));
    }
    {
        const int hh = tid >> 7, ww = tid & 127;
        const LAS float* kp = Ks + ww * 65; const LAS float* qp = qs + hh * 64;
        float sc = 0.f;
#pragma unroll 16
        for (int d = 0; d < 64; ++d) sc += qp[d] * kp[d];
        ps[hh * 128 + ww] = sc + btab[(4 * g + hh) * 128 + 127 - ww];
    }
    __syncthreads();    if (tid < 256) {
        const float sa = ps[w * 128 + lane], sb = ps[w * 128 + 64 + lane];
        const float sk = skv * LOG2E;
        float m = fmaxf(fmaxf(sa, sb), sk);
#pragma unroll
        for (int o2 = 32; o2 > 0; o2 >>= 1) m = fmaxf(m, __shfl_xor(m, o2));
        const float p0 = ex2(sa - m), p1 = ex2(sb - m);
        const float l = wave_sum(p0 + p1) + ex2(sk - m);
        const float il = 1.0f / l;
        ps[w * 128 + lane] = p0 * il; ps[w * 128 + 64 + lane] = p1 * il;
        LDS_WAIT(); __builtin_amdgcn_wave_barrier();
        const LAS float* vp = Vs + lane; const LAS float* pp = ps + w * 128;
        float o = 0.f;
#pragma unroll 16
        for (int k = 0; k < 128; ++k) o += pp[k] * vp[k * 64];
        st_wt16(S.MIX + r * DM + 512 + ch, pg8::cvt_pk_bf16(o * __uint_as_float(sgau << 16), 0.f));
    }
    VM_WAIT(); __syncthreads();    if (tid == 0) __hip_atomic_fetch_add(cnt, 1u, __ATOMIC_RELAXED, __HIP_MEMORY_SCOPE_AGENT);
    {
        float* okb = S.out + O_KS + (size_t)b * 16384 + g * 64; float* ovb = S.out + O_VS + (size_t)b * 16384 + g * 64;
#pragma unroll
        for (int i = 0; i < 4; ++i) { const int e = tid + 512 * i; if (e < 127 * 16) { const int ww = e >> 4, d = (e & 15) * 4; __builtin_nontemporal_store(kk[i], (f32x4*)(okb + ww * 128 + d)); __builtin_nontemporal_store(vv[i], (f32x4*)(ovb + ww * 128 + d)); } }
    }
}

template <int NLOADS>
__device__ __forceinline__ unsigned l2_warm_issue(v4u (&pf)[NLOADS], const void* base, int tid) {
    const char* p = (const char*)base + ((size_t)(((blockIdx.x >> 3) & 31) * 8 + (tid >> 6)) * NLOADS) * 1024 + (tid & 63) * 16;
#pragma unroll
    for (int i = 0; i < NLOADS; ++i) pf[i] = *(const v4u*)(p + i * 1024);
    return 0u;
}
template <int NLOADS>
__device__ __forceinline__ void l2_warm_retire(const v4u (&pf)[NLOADS], unsigned* sink) {
    unsigned a = 0u;
#pragma unroll
    for (int i = 0; i < NLOADS; ++i) a |= pf[i].x ^ pf[i].y ^ pf[i].z ^ pf[i].w;
    if (a == 0x9E3779B9u && threadIdx.x == 12345) *sink = a;
}
constexpr int A_LO = A_RNN, A_HI = A_ATT, A_RS = A_PART;
struct ProjArgs { const float* x; const bf16 *WA, *WB, *WKV; bf16 *XR, *SGR, *Q, *SGA, *KV; float* out; unsigned* sink; bf16* XB2; };
#define AS_LOADB(dst, wfp, NTT, ks) do { _Pragma("unroll") for (int nt = 0; nt < NTT; ++nt) dst[nt] = *(const bf16x8*)((wfp) + (size_t)(((ks) * NTT + nt) * 512)); } while (0)
#define AS_STEP(accv, bw, NTT, ks) do { bf16x8 af[4]; const LAS unsigned char* ap = abase + (((ks) < 16) ? A_LO : A_HI) + (((ks) & 15) * 64); \
        _Pragma("unroll") for (int mt = 0; mt < 4; ++mt) af[mt] = *(const LAS bf16x8*)(ap + mt * 16 * A_STRIDE); \
        _Pragma("unroll") for (int mt = 0; mt < 4; ++mt) _Pragma("unroll") for (int nt = 0; nt < NTT; ++nt) accv[mt][nt] = __builtin_amdgcn_mfma_f32_16x16x32_bf16(bw[nt], af[mt], accv[mt][nt], 0, 0, 0); } while (0)
__device__ __forceinline__ v4u pack8(f32x4 a, f32x4 b) { v4u o; o.x = pg8::cvt_pk_bf16(a.x, a.y); o.y = pg8::cvt_pk_bf16(a.z, a.w); o.z = pg8::cvt_pk_bf16(b.x, b.y); o.w = pg8::cvt_pk_bf16(b.z, b.w); return o; }
__device__ __forceinline__ f32x4 silu4(f32x4 v) { f32x4 o; o.x = silu_(v.x); o.y = silu_(v.y); o.z = silu_(v.z); o.w = silu_(v.w); return o; }
template <int PASS>
__device__ __forceinline__ void proj_pass(const LAS unsigned char* abase, size_t row0, int w, int lane, int fr, int fq, const float (&rs)[4], const bf16* W, bf16* dlo, bf16* dhi, float* out) {
    const bf16* wf = W + (size_t)w * (32 * 8 * 64 * 8) + lane * 8;
    f32x4 acc[4][8];
#pragma unroll
    for (int mt = 0; mt < 4; ++mt)
#pragma unroll
        for (int nt = 0; nt < 8; ++nt) acc[mt][nt] = (f32x4){0.f, 0.f, 0.f, 0.f};
    bf16x8 b0[8], b1[8], b2[8];
    AS_LOADB(b0, wf, 8, 0); AS_LOADB(b1, wf, 8, 1);
#pragma unroll 1
    for (int ks = 0; ks < 30; ks += 3) {
        AS_LOADB(b2, wf, 8, ks + 2); __builtin_amdgcn_sched_barrier(0);
        AS_STEP(acc, b0, 8, ks); __builtin_amdgcn_sched_barrier(0);
        AS_LOADB(b0, wf, 8, ks + 3); __builtin_amdgcn_sched_barrier(0);
        AS_STEP(acc, b1, 8, ks + 1); __builtin_amdgcn_sched_barrier(0);
        AS_LOADB(b1, wf, 8, (ks + 4 < 32 ? ks + 4 : 31)); __builtin_amdgcn_sched_barrier(0);
        AS_STEP(acc, b2, 8, ks + 2); __builtin_amdgcn_sched_barrier(0);
    }
    AS_STEP(acc, b0, 8, 30); __builtin_amdgcn_sched_barrier(0);
    AS_STEP(acc, b1, 8, 31); __builtin_amdgcn_sched_barrier(0);
    bf16* dst = (w < 4) ? dlo : dhi;
    const int colw = 128 * (w & 3) + 8 * fq;
#pragma unroll
    for (int mt = 0; mt < 4; ++mt) { const size_t row = row0 + 16 * mt + fr;
#pragma unroll
        for (int p = 0; p < 4; ++p) { f32x4 v0 = acc[mt][2 * p] * rs[mt], v1 = acc[mt][2 * p + 1] * rs[mt];
            if (w >= 4) { v0 = silu4(v0); v1 = silu4(v1); } else if (PASS) { v0 = v0 * QSCALE; v1 = v1 * QSCALE; }
            *(v4u*)(dst + row * 512 + colw + 32 * p) = pack8(v0, v1);
            if (PASS == 0 && w < 4) { const int j = (int)(row & (SEQ - 1)) - (SEQ - 3);
                if (j >= 0) { float* o = out + O_CP + (size_t)((row >> 13) * 3 + j) * 512 + colw + 32 * p; *(f32x4*)o = v0; *(f32x4*)(o + 4) = v1; } } } }
}
__device__ __forceinline__ void proj_unit(LAS unsigned char* lds, int u, const ProjArgs& P) {
    int tid = threadIdx.x; asm volatile("" : "+v"(tid));
    const int lane = tid & 63, w = __builtin_amdgcn_readfirstlane(tid >> 6), fr = lane & 15, fq = lane >> 4;
    const size_t row0 = (size_t)u * 64;
    LAS float* rsl = (LAS float*)(lds + A_RS);
    {
        v4u pfa[8]; l2_warm_issue<8>(pfa, P.WA, tid);
        f32x4 v[8][4];
#pragma unroll
        for (int r = 0; r < 8; ++r)
#pragma unroll
            for (int j = 0; j < 4; ++j) v[r][j] = __builtin_nontemporal_load((const f32x4*)(P.x + (row0 + 8 * w + r) * DM) + lane + 64 * j);
        __builtin_amdgcn_sched_barrier(0);
#pragma unroll
        for (int r = 0; r < 8; ++r) { const int row = 8 * w + r; float s = 0.f;
#pragma unroll
            for (int j = 0; j < 4; ++j) { s += (v[r][j].x * v[r][j].x + v[r][j].y * v[r][j].y) + (v[r][j].z * v[r][j].z + v[r][j].w * v[r][j].w);
                v2u o; o.x = pg8::cvt_pk_bf16(v[r][j].x, v[r][j].y); o.y = pg8::cvt_pk_bf16(v[r][j].z, v[r][j].w);
                *(LAS v2u*)(lds + (j < 2 ? A_LO : A_HI) + row * A_STRIDE + ((4 * lane + 256 * j) & 511) * 2) = o;
                *(v2u*)(P.XB2 + (row0 + row) * DM + 4 * lane + 256 * j) = o; }
            s = wave_sum(s);
            if (lane == 0) rsl[row] = rsqrtf(s * (1.0f / DM) + EPS); }
        v4u pfb[8], pfc[2]; l2_warm_issue<8>(pfb, P.WB, tid); l2_warm_issue<2>(pfc, P.WKV, tid);
        __builtin_amdgcn_sched_barrier(0);
        l2_warm_retire<8>(pfa, P.sink); l2_warm_retire<8>(pfb, P.sink); l2_warm_retire<2>(pfc, P.sink);
    }
    LDS_WAIT(); __syncthreads();
    const LAS unsigned char* abase = lds + fr * A_STRIDE + fq * 16;
    float rs[4];
#pragma unroll
    for (int mt = 0; mt < 4; ++mt) rs[mt] = rsl[16 * mt + fr];
    proj_pass<0>(abase, row0, w, lane, fr, fq, rs, P.WA, P.XR, P.SGR, P.out);
    proj_pass<1>(abase, row0, w, lane, fr, fq, rs, P.WB, P.Q, P.SGA, P.out);
    {
        const bf16* wf = P.WKV + (size_t)w * (32 * 2 * 64 * 8) + lane * 8;
        f32x4 acc[4][2];
#pragma unroll
        for (int mt = 0; mt < 4; ++mt)
#pragma unroll
            for (int nt = 0; nt < 2; ++nt) acc[mt][nt] = (f32x4){0.f, 0.f, 0.f, 0.f};
        bf16x8 bA[8][2], bB[8][2];
#define KV_LOADB(dst, k0) do { _Pragma("unroll") for (int k = 0; k < 8; ++k) AS_LOADB(dst[k], wf, 2, (k0) + k); } while (0)
#define KV_COMPUTE(bw, k0) do { _Pragma("unroll") for (int k = 0; k < 8; ++k) AS_STEP(acc, bw[k], 2, (k0) + k); } while (0)
        KV_LOADB(bA, 0); KV_LOADB(bB, 8); __builtin_amdgcn_sched_barrier(0);
        KV_COMPUTE(bA, 0);  __builtin_amdgcn_sched_barrier(0); KV_LOADB(bA, 16); __builtin_amdgcn_sched_barrier(0);
        KV_COMPUTE(bB, 8);  __builtin_amdgcn_sched_barrier(0); KV_LOADB(bB, 24); __builtin_amdgcn_sched_barrier(0);
        KV_COMPUTE(bA, 16); __builtin_amdgcn_sched_barrier(0);
        KV_COMPUTE(bB, 24); __builtin_amdgcn_sched_barrier(0);
#undef KV_LOADB
#undef KV_COMPUTE
        const int col = 32 * w + 8 * fq;
#pragma unroll
        for (int mt = 0; mt < 4; ++mt) { const size_t row = row0 + 16 * mt + fr; const int wi = (int)(row & (SEQ - 1)) - (SEQ - WIN);
            const f32x4 v0 = acc[mt][0] * rs[mt], v1 = acc[mt][1] * rs[mt];
            *(v4u*)(P.KV + row * 256 + col) = pack8(v0, v1);
            if (wi >= 0) { float* o = P.out + (col < 128 ? O_KP : O_VP) + (size_t)((row >> 13) * WIN + wi) * 128 + (col & 127); *(f32x4*)o = v0; *(f32x4*)(o + 4) = v1; } }
    }
    __syncthreads();
}
struct SprojArgs { const bf16* XB; const bf16 *WA, *WB, *WKV; const float* RSTD; bf16 *XR, *SGR, *Q, *KV, *SGA; float* out; };
__device__ __forceinline__ void sample_proj_unit(LAS unsigned char* lds, int sl, const SprojArgs& P) {
    int tid = threadIdx.x; asm volatile("" : "+v"(tid));
    const int lane = tid & 63, w = __builtin_amdgcn_readfirstlane(tid >> 6), fr = lane & 15, fq = lane >> 4;
    const int rg = sl / 36, cg = sl % 36, pass = cg >> 4;
    const bf16* wa_ = P.WA; const bf16* wb_ = P.WB; const bf16* wkv_ = P.WKV;
    const bf16* ap = P.XB + (size_t)(MP + 32 * rg + fr) * DM + 128 * w + 8 * fq;
    bf16x8 af[2][4], bw[4][4];
#pragma unroll
    for (int j = 0; j < 4; ++j) {
        const int slab = pass < 2 ? (cg >> 1) & 7 : 2 * (cg - 32) + (j >> 1), nta = pass < 2 ? 4 * (cg & 1) + j : (j & 1), NTT = pass < 2 ? 8 : 2;
        const bf16* bp = (pass == 0 ? wa_ : pass == 1 ? wb_ : wkv_) + ((size_t)(slab * 32 * NTT + nta) * 64 + lane) * 8;
#pragma unroll
        for (int k = 0; k < 4; ++k) bw[j][k] = *(const bf16x8*)(bp + (size_t)(4 * w + k) * NTT * 512); }
#pragma unroll
    for (int mt = 0; mt < 2; ++mt)
#pragma unroll
        for (int k = 0; k < 4; ++k) af[mt][k] = *(const bf16x8*)(ap + (size_t)(16 * mt) * DM + 32 * k);
    const int tmt = w >> 2, tj = w & 3;
    const float rstd_row = P.RSTD[(size_t)MP + 32 * rg + 16 * tmt + fr];
    __builtin_amdgcn_sched_barrier(0);
    LAS float* red = (LAS float*)lds;
#pragma unroll
    for (int mt = 0; mt < 2; ++mt)
#pragma unroll
        for (int j = 0; j < 4; ++j) { f32x4 acc = {0.f, 0.f, 0.f, 0.f};
#pragma unroll
            for (int k = 0; k < 4; ++k) acc = __builtin_amdgcn_mfma_f32_16x16x32_bf16(bw[j][k], af[mt][k], acc, 0, 0, 0);
            *(LAS f32x4*)(red + ((w * 8 + mt * 4 + j) * 64 + lane) * 4) = acc; }
    LDS_WAIT(); __syncthreads();
    f32x4 v = {0.f, 0.f, 0.f, 0.f};
#pragma unroll
    for (int ww = 0; ww < 8; ++ww) v += *(const LAS f32x4*)(red + ((ww * 8 + w) * 64 + lane) * 4);
    const int b = 32 * rg + 16 * tmt + fr; const size_t row = (size_t)MP + b;
    v = v * rstd_row;
    const int slab = pass < 2 ? (cg >> 1) & 7 : 2 * (cg - 32) + (tj >> 1), nt = pass < 2 ? 4 * (cg & 1) + tj : (tj & 1);
    const int cin = 32 * (nt >> 1) + 8 * fq + 4 * (nt & 1);
    v2u o;
    if (pass < 2) { const int col = 128 * (slab & 3) + cin;
        if (slab >= 4) v = silu4(v); else if (pass) v = v * QSCALE;
        o.x = pg8::cvt_pk_bf16(v.x, v.y); o.y = pg8::cvt_pk_bf16(v.z, v.w);
        bf16* q_ = P.Q; bf16* sga_ = P.SGA; bf16* xr_ = P.XR; bf16* sgr_ = P.SGR;
        bf16* dst = pass ? (slab < 4 ? q_ : sga_) : (slab < 4 ? xr_ : sgr_);
        *(v2u*)(dst + row * 512 + col) = o;
        if (pass == 0 && slab < 4) *(f32x4*)(P.out + O_CS + (size_t)(b * 3 + 2) * 512 + col) = v; }
    else { const int col = 32 * slab + cin;
        o.x = pg8::cvt_pk_bf16(v.x, v.y); o.y = pg8::cvt_pk_bf16(v.z, v.w);
        *(v2u*)(P.KV + row * 256 + col) = o;
        *(f32x4*)(P.out + (col < 128 ? O_KS : O_VS) + (size_t)b * 16384 + 127 * 128 + (col & 127)) = v; }
    __syncthreads();
}

__device__ __forceinline__ void out_unit(LAS unsigned char* lds, int b, int c, const unsigned* UV, const bf16* ATT, const float* AGG, const bf16* WF, const bf16* x, const float* gpost, float* y, float* out) {
    int tid = threadIdx.x; asm volatile("" : "+v"(tid));
    const int lane = tid & 63, w = __builtin_amdgcn_readfirstlane(tid >> 6), fr = lane & 15, fq = lane >> 4;
    const size_t row0 = (size_t)b * SEQ + 64 * c;
    v4u pfo[8]; l2_warm_issue<8>(pfo, WF, tid);
    {
        const float* ag = AGG + (size_t)b * NCHUNK * 1024 + tid;
        const int q = c >> 3;
        float pa[8], pb[8];
#pragma unroll
        for (int k = 0; k < 8; ++k) { pa[k] = 1.f; pb[k] = 0.f; }
        float ta[7], tb[7];
#pragma unroll
        for (int jj = 0; jj < 7; ++jj) { const int j = (8 * q + jj < c) ? 8 * q + jj : (c > 0 ? c - 1 : 0); ta[jj] = ag[(size_t)j * 1024]; tb[jj] = ag[(size_t)j * 1024 + 512]; }
        const float ca = ag[(size_t)c * 1024], cb = ag[(size_t)c * 1024 + 512];
        __builtin_amdgcn_sched_barrier(0);
#pragma unroll 1
        for (int j0 = 0; j0 < q; j0 += 8) {
            float A[8][8], B[8][8];
#pragma unroll
            for (int k = 0; k < 8; ++k)
#pragma unroll
                for (int jj = 0; jj < 8; ++jj) { const int j = (j0 + jj < q) ? j0 + jj : q - 1; A[k][jj] = ag[(size_t)(k * q + j) * 1024]; B[k][jj] = ag[(size_t)(k * q + j) * 1024 + 512]; }
            __builtin_amdgcn_sched_barrier(0);
#pragma unroll
            for (int jj = 0; jj < 8; ++jj) if (j0 + jj < q) {
#pragma unroll
                for (int k = 0; k < 8; ++k) { pb[k] = A[k][jj] * pb[k] + B[k][jj]; pa[k] *= A[k][jj]; } }
            __builtin_amdgcn_sched_barrier(0);
        }
        float hin = pb[0];
#pragma unroll
        for (int k = 1; k < 8; ++k) hin = pa[k] * hin + pb[k];
#pragma unroll
        for (int jj = 0; jj < 7; ++jj) if (8 * q + jj < c) hin = ta[jj] * hin + tb[jj];
        ((LAS float*)(lds + A_HIN))[tid] = hin;
        l2_warm_retire<8>(pfo, (unsigned*)(out + O_RP));
        if (c == NCHUNK - 1) out[O_RP + b * 512 + tid] = ca * hin + cb;
    }
    VM_WAIT(); __syncthreads();
    {   typedef f16 f16x8 __attribute__((ext_vector_type(8)));
        f16x8 p0[8], p1[8]; v4u at[8];
#pragma unroll
        for (int i = 0; i < 8; ++i) { const int e = tid + 512 * i, r = e >> 6, cc = e & 63;
            p0[i] = *(const f16x8*)(UV + (row0 + r) * 512 + cc * 8); p1[i] = *(const f16x8*)(UV + (row0 + r) * 512 + cc * 8 + 4);
            at[i] = *(const v4u*)(ATT + (row0 + r) * 512 + cc * 8); }
        __builtin_amdgcn_sched_barrier(0);
        LDS_WAIT(); __syncthreads();
#pragma unroll
        for (int i = 0; i < 8; ++i) { const int e = tid + 512 * i, r = e >> 6, cc = e & 63;
            const f32x4 h0 = *(const LAS f32x4*)(lds + A_HIN + cc * 32), h1 = *(const LAS f32x4*)(lds + A_HIN + cc * 32 + 16);
            v4u o; o.x = pg8::cvt_pk_bf16((float)p0[i][0] + (float)p0[i][1] * h0.x, (float)p0[i][2] + (float)p0[i][3] * h0.y); o.y = pg8::cvt_pk_bf16((float)p0[i][4] + (float)p0[i][5] * h0.z, (float)p0[i][6] + (float)p0[i][7] * h0.w);
            o.z = pg8::cvt_pk_bf16((float)p1[i][0] + (float)p1[i][1] * h1.x, (float)p1[i][2] + (float)p1[i][3] * h1.y); o.w = pg8::cvt_pk_bf16((float)p1[i][4] + (float)p1[i][5] * h1.z, (float)p1[i][6] + (float)p1[i][7] * h1.w);
            *(LAS v4u*)(lds + A_RNN + r * A_STRIDE + cc * 16) = o; *(LAS v4u*)(lds + A_ATT + r * A_STRIDE + cc * 16) = at[i]; }
    }
    LDS_WAIT(); __syncthreads();
    f32x4 acc[4][8];
#pragma unroll
    for (int mt = 0; mt < 4; ++mt)
#pragma unroll
        for (int nt = 0; nt < 8; ++nt) acc[mt][nt] = (f32x4){0.f, 0.f, 0.f, 0.f};
    const bf16* wf = WF + (size_t)w * (32 * 8 * 64 * 8) + lane * 8;
    const LAS unsigned char* abase = lds + fr * A_STRIDE + fq * 16;
    bf16x8 b0[8], b1[8];
#define OU_LOADB(dst, ks) do { _Pragma("unroll") for (int nt = 0; nt < 8; ++nt) dst[nt] = *(const bf16x8*)(wf + (size_t)(((ks) * 8 + nt) * 512)); } while (0)
#define OU_STEP(bw, ks) do { bf16x8 af[4]; const LAS unsigned char* ap = abase + (((ks) < 16) ? A_RNN : A_ATT) + (((ks) & 15) * 64); \
        _Pragma("unroll") for (int mt = 0; mt < 4; ++mt) af[mt] = *(const LAS bf16x8*)(ap + mt * 16 * A_STRIDE); \
        _Pragma("unroll") for (int mt = 0; mt < 4; ++mt) _Pragma("unroll") for (int nt = 0; nt < 8; ++nt) acc[mt][nt] = __builtin_amdgcn_mfma_f32_16x16x32_bf16(bw[nt], af[mt], acc[mt][nt], 0, 0, 0); } while (0)
    OU_LOADB(b0, 0);
#pragma unroll 1
    for (int ks = 0; ks < 32; ks += 2) {
        OU_LOADB(b1, ks + 1); __builtin_amdgcn_sched_barrier(0);
        OU_STEP(b0, ks); __builtin_amdgcn_sched_barrier(0);
        OU_LOADB(b0, (ks + 2 < 32 ? ks + 2 : 31)); __builtin_amdgcn_sched_barrier(0);
        OU_STEP(b1, ks + 1); __builtin_amdgcn_sched_barrier(0);
    }
#undef OU_LOADB
#undef OU_STEP
    int tid2 = threadIdx.x; asm volatile("" : "+v"(tid2)); const int fr2 = tid2 & 15, fq2 = (tid2 >> 4) & 3;
    LAS float* part = (LAS float*)(lds + A_PART);
#pragma unroll
    for (int mt = 0; mt < 4; ++mt) { float ss = 0.f;
#pragma unroll
        for (int nt = 0; nt < 8; ++nt) { const f32x4 v = acc[mt][nt]; ss += (v.x * v.x + v.y * v.y) + (v.z * v.z + v.w * v.w); }
        ss += __shfl_xor(ss, 16); ss += __shfl_xor(ss, 32);
        if (fq2 == 0) part[w * 64 + 16 * mt + fr2] = ss; }
    LDS_WAIT(); __syncthreads();
    constexpr int YS = 4112;
    const int lane2 = tid2 & 63;
    f32x4 gv[4];
#pragma unroll
    for (int j = 0; j < 4; ++j) gv[j] = *(const f32x4*)(gpost + 4 * lane2 + 256 * j);
    v2u xv[2][2][4];
    const bf16* xb0 = x + (row0 + 2 * w) * DM + 4 * lane2;
#pragma unroll
    for (int rr = 0; rr < 2; ++rr)
#pragma unroll
        for (int j = 0; j < 4; ++j) xv[0][rr][j] = __builtin_nontemporal_load((const v2u*)(xb0 + (size_t)rr * DM + 256 * j));
    __builtin_amdgcn_sched_barrier(0);
#pragma unroll
    for (int mt = 0; mt < 4; ++mt) { float ss = 0.f;
        if (mt < 3) {
#pragma unroll
            for (int rr = 0; rr < 2; ++rr)
#pragma unroll
                for (int j = 0; j < 4; ++j) xv[(mt + 1) & 1][rr][j] = __builtin_nontemporal_load((const v2u*)(xb0 + (size_t)(16 * (mt + 1) + rr) * DM + 256 * j));
        }
        __builtin_amdgcn_sched_barrier(0);
#pragma unroll
        for (int ww = 0; ww < 8; ++ww) ss += part[ww * 64 + 16 * mt + fr2];
        const float rs = rsqrtf(ss * (1.0f / DM) + EPS);
#pragma unroll
        for (int nt = 0; nt < 8; ++nt) *(LAS f32x4*)(lds + fr2 * YS + (128 * w + 16 * nt + 4 * fq2) * 4) = acc[mt][nt] * rs;
        LDS_WAIT(); __syncthreads();
#pragma unroll
        for (int rr = 0; rr < 2; ++rr)
#pragma unroll
            for (int j = 0; j < 4; ++j) { const f32x4 v = *(const LAS f32x4*)(lds + (2 * w + rr) * YS + (4 * lane2 + 256 * j) * 4);
                const v2u xq = xv[mt & 1][rr][j]; const f32x4 xf = {__uint_as_float(xq.x << 16), __uint_as_float(xq.x & 0xffff0000u), __uint_as_float(xq.y << 16), __uint_as_float(xq.y & 0xffff0000u)};
                __builtin_nontemporal_store(xf + v * gv[j], (f32x4*)(y + (row0 + 16 * mt + 2 * w + rr) * DM + 4 * lane2 + 256 * j)); }
        LDS_WAIT(); __syncthreads(); }
}
typedef unsigned long long u64x2 __attribute__((ext_vector_type(2)));
__device__ __forceinline__ u64x2 ld16_sc1(const void* p) { const unsigned long long* q = (const unsigned long long*)p;
    u64x2 r; r.x = __hip_atomic_load(q, __ATOMIC_RELAXED, __HIP_MEMORY_SCOPE_AGENT); r.y = __hip_atomic_load(q + 1, __ATOMIC_RELAXED, __HIP_MEMORY_SCOPE_AGENT); return r; }
__device__ __forceinline__ void sample_out_unit(LAS unsigned char* lds, int su, const bf16* MIX, const bf16* WF, float* OUTS) {
    int tid = threadIdx.x; asm volatile("" : "+v"(tid));
    const int lane = tid & 63, w = __builtin_amdgcn_readfirstlane(tid >> 6), fr = lane & 15, fq = lane >> 4;
    const int rg = su >> 4, cg = su & 15;
    const bf16* bp = WF + ((size_t)((cg >> 1) * 32 * 8 + 4 * (cg & 1)) * 64 + lane) * 8;
    const bf16* ap = MIX + (size_t)(MP + 32 * rg + fr) * DM + 128 * w + 8 * fq;
    bf16x8 af[2][4], bw[4][4];
#pragma unroll
    for (int k = 0; k < 4; ++k) {
#pragma unroll
        for (int j = 0; j < 4; ++j) bw[j][k] = *(const bf16x8*)(bp + (size_t)(4 * w + k) * 8 * 512 + j * 512);
#pragma unroll
        for (int mt = 0; mt < 2; ++mt) af[mt][k] = *(const bf16x8*)(ap + (size_t)(16 * mt) * DM + 32 * k); }
    __builtin_amdgcn_sched_barrier(0);
    LAS float* red = (LAS float*)lds;
#pragma unroll
    for (int mt = 0; mt < 2; ++mt)
#pragma unroll
        for (int j = 0; j < 4; ++j) { f32x4 acc = {0.f, 0.f, 0.f, 0.f};
#pragma unroll
            for (int k = 0; k < 4; ++k) acc = __builtin_amdgcn_mfma_f32_16x16x32_bf16(bw[j][k], af[mt][k], acc, 0, 0, 0);
            *(LAS f32x4*)(red + ((w * 8 + mt * 4 + j) * 64 + lane) * 4) = acc; }
    LDS_WAIT(); __syncthreads();
    f32x4 v = {0.f, 0.f, 0.f, 0.f};
#pragma unroll
    for (int ww = 0; ww < 8; ++ww) v += *(const LAS f32x4*)(red + ((ww * 8 + w) * 64 + lane) * 4);
    { float* op = OUTS + (size_t)(32 * rg + 16 * (w >> 2) + fr) * DM + 128 * (cg >> 1) + 16 * (4 * (cg & 1) + (w & 3)) + 4 * fq;
      asm volatile("global_store_dwordx4 %0, %1, off sc0 sc1\n\ts_nop 1" :: "v"(op), "v"(v) : "memory"); }
    __syncthreads();
}

#ifndef MK_N_LAUNCHES
#define MK_N_LAUNCHES 1
#endif
constexpr int N_PHASES = 3;
struct Args { const float* in[19]; float* out; unsigned char* ws; int ph_lo, ph_hi; };
static_assert(sizeof(Args) == 19 * 8 + 8 + 8 + 8, "Args has no padding");

__global__ void __launch_bounds__(512, 2) mk_fwd(Args args) {
    extern __shared__ __attribute__((aligned(16))) unsigned char lds_raw[];
    LAS unsigned char* lds = (LAS unsigned char*)lds_raw;
    volatile LAS unsigned* MISC = (volatile LAS unsigned*)(lds + MISC_OFF);
    const int tid = threadIdx.x, lane = tid & 63, wave = __builtin_amdgcn_readfirstlane(tid >> 6);
    const int G = gridDim.x, bid = blockIdx.x;
    unsigned char* ws = args.ws; float* out = args.out;
    const float* x_prompt = args.in[0]; const float* x_sample = args.in[1]; const float* state_conv = args.in[2]; const float* state_rnn = args.in[3];
    const float* cache_k = args.in[4]; const float* cache_v = args.in[5]; const float* norm_pre = args.in[6]; const float* norm_post = args.in[7];
    const float* w_in = args.in[8]; const float* conv_w = args.in[9]; const float* conv_b = args.in[10]; const float* w_a = args.in[11]; const float* b_a = args.in[12];
    const float* w_x = args.in[13]; const float* b_x = args.in[14]; const float* lam = args.in[15]; const float* sinks = args.in[16]; const float* rel_bias = args.in[17];
    const float* w_out = args.in[18];
    bf16* WA = (bf16*)(ws + WS_WA); bf16* WB = (bf16*)(ws + WS_WB); bf16* WT_OUT = (bf16*)(ws + WS_WOUT); bf16* WG = (bf16*)(ws + WS_WG); bf16* WKV = (bf16*)(ws + WS_WKV); float* RSTD = (float*)(ws + WS_RSTD); float* AGG = (float*)(ws + WS_AGG);
    bf16* XB = (bf16*)(ws + WS_XB); bf16* XR = (bf16*)(ws + WS_XR); bf16* SGR = (bf16*)(ws + WS_SGR); bf16* Qb = (bf16*)(ws + WS_Q); bf16* SGA = (bf16*)(ws + WS_SGA);
    bf16* KV = (bf16*)(ws + WS_KV); bf16* MIX = (bf16*)(ws + WS_MIX); float* OUTS = (float*)(ws + WS_OUTS);
    unsigned* ctl = (unsigned*)(ws + WS_CTL);

    if (wave >= 4) __builtin_amdgcn_s_setprio(1);
    for (int u = tid; u < (LDS_BYTES - LDSCTL_OFF) / 4; u += 512) ((LAS unsigned*)(lds + LDSCTL_OFF))[u] = 0u;
    __syncthreads();
    XcdBarrier bar; bar.bar = ctl + CW_BAR; bar.x = 0; bar.st = nullptr;
    if (MK_N_LAUNCHES == 1) bar = xcd_barrier_post(ctl + CW_BAR, MISC + 8);
    const int lo = args.ph_lo, hi = args.ph_hi;
    SmpPre spre;
#pragma unroll
    for (int i = 0; i < 4; ++i) { spre.kk[i] = (f32x4){0.f, 0.f, 0.f, 0.f}; spre.vv[i] = (f32x4){0.f, 0.f, 0.f, 0.f}; }
#define IN(k) (lo <= (k) && (k) < hi)
#define BOTH(k) (IN(k) && IN((k) + 1))
#define GRID_BAR() do { if (MK_N_LAUNCHES == 1) xcd_barrier(bar); } while (0)

    if (IN(0)) {
        LAS float* scr = (LAS float*)(lds + wave * 16384);
        const int gw = wave * G + bid, NGW = G * 8;
        constexpr int I_IN = (DM / 64) * (DIN / 32), I_OUT = (DM / 64) * (DM / 32), I_G = 16 * 2;
        for (int it = gw; it < I_IN + I_OUT + I_G; it += NGW) {
            int r = it;
            if (r < I_IN) { const int n0 = 32 * (r % (DIN / 32));
                if (n0 < 1024) p0_transpose_item<3>(w_in, DM, DIN, WA, norm_pre, scr, r, lane, n0);
                else if (n0 < 1536) p0_transpose_item<3>(w_in, DM, DIN, WB, norm_pre, scr, r, lane, n0 - 1024);
                else if (n0 < 1792) p0_transpose_item<4>(w_in, DM, DIN, WKV, norm_pre, scr, r, lane, n0 - 1536);
                else p0_transpose_item<3>(w_in, DM, DIN, WB, norm_pre, scr, r, lane, n0 - 1792 + 512);
                continue; } r -= I_IN;
            if (r < I_OUT) { p0_transpose_item<1>(w_out, DM, DM, WT_OUT, nullptr, scr, r, lane, 32 * (r % (DM / 32))); continue; } r -= I_OUT;
            { const int mat = r >> 1, blk = mat >> 1, gate = mat & 1; p0_transpose_item<0>((gate ? w_x : w_a) + blk * 4096, 64, 64, WG + (size_t)mat * 4096, nullptr, scr, r & 1, lane, 32 * (r & 1), -LOG2E); }
        }
        for (int m0 = MP + (NGW - 1 - gw) * 8; m0 < MT; m0 += NGW * 8) {
            const float* xr[8]; bf16* orow[8]; float* rsp[8];
#pragma unroll
            for (int r = 0; r < 8; ++r) { const int m = m0 + r; xr[r] = x_sample + (size_t)(m - MP) * DM; orow[r] = XB + (size_t)m * DM; rsp[r] = RSTD + m; }
            p0_rows<8>(xr, orow, rsp, lane);
        }
        if (BOTH(0)) GRID_BAR();
    }
    if (IN(1)) {
        {
            ProjArgs PA{x_prompt, WA, WB, WKV, XR, SGR, Qb, SGA, KV, out, ctl + 960, (bf16*)(ws + WS_XB2)};
            SprojArgs SP{XB, WA, WB, WKV, RSTD, XR, SGR, Qb, KV, SGA, out};
            const int nsl = DIN / 16;
            const int sl_first = ((bid & 1) && (bid >> 1) < 128) ? (bid >> 1) : -1, sl_last = (!(bid & 1) && (bid >> 1) < nsl - 128 && G >= 256) ? 128 + (bid >> 1) : -1;
            if (G >= 256) { if (sl_first >= 0) sample_proj_unit(lds, sl_first, SP); }
            else for (int sl = bid; sl < nsl; sl += G) sample_proj_unit(lds, sl, SP);
            for (int u = bid; u < MP / 64; u += G) proj_unit(lds, u, PA);
            if (sl_last >= 0) sample_proj_unit(lds, sl_last, SP);
        }
        if (BOTH(1)) {
            LAS float* btab0 = (LAS float*)(lds + BTAB_OFF);
            for (int e = tid; e < 1024; e += 512) { const int h = e >> 7, d = e & 127; btab0[e] = rel_bias[t5_bucket(d) * NH + h] * LOG2E; }
            attn_table(lds, rel_bias);
            if (bid < 2 * DECB && !(G >= 256 && ((bid >> 1) & 1))) sample_prefetch(spre, cache_k, cache_v, bid >> 1, bid & 1, tid);
            GRID_BAR();
        }
    }
    if (IN(2)) {
        LAS float* btab = (LAS float*)(lds + BTAB_OFF);
        const bool pre_ok = BOTH(1);
        if (!pre_ok) { for (int e = tid; e < 1024; e += 512) { const int h = e >> 7, d = e & 127; btab[e] = rel_bias[t5_bucket(d) * NH + h] * LOG2E; } }
        __syncthreads();
        RgArgs R{XR, SGR, WG, conv_w, conv_b, b_a, b_x, lam, AGG, (unsigned*)XB};
        SmpArgs SA{XR, SGR, Qb, KV, SGA, WG, state_conv, state_rnn, cache_k, cache_v, conv_w, conv_b, b_a, b_x, lam, sinks, MIX, out};
        const bool r_first = G >= 256 && ((bid >> 1) & 1);
        if (!r_first) {
            if (pre_ok && bid < 2 * DECB) { sample_unit<true>(lds, btab, SA, bid >> 1, bid & 1, ctl + CW_SMP, spre);
                for (int u = bid + G; u < 2 * DECB; u += G) sample_unit<false>(lds, btab, SA, u >> 1, u & 1, ctl + CW_SMP, spre); }
            else for (int u = bid; u < 2 * DECB; u += G) sample_unit<false>(lds, btab, SA, u >> 1, u & 1, ctl + CW_SMP, spre);
        }
        for (int u = bid; u < BATCH * NCHUNK; u += G) { rglru_unit(lds, R, u / NCHUNK, u % NCHUNK);
            if (tid == 0) __hip_atomic_fetch_add(ctl + CW_AGG, 1u, __ATOMIC_RELAXED, __HIP_MEMORY_SCOPE_AGENT); }
        if (r_first) for (int u = bid; u < 2 * DECB; u += G) sample_unit<false>(lds, btab, SA, u >> 1, u & 1, ctl + CW_SMP, spre);
        {
            bool waited = false;
            const int sob = G >= 192 ? 128 : 0;
            for (int su = bid - sob; su >= 0 && su < 64; su += G) {
                if (!waited) {
                    if (tid == 0) { unsigned sp = 0; while (__hip_atomic_load(ctl + CW_SMP, __ATOMIC_RELAXED, __HIP_MEMORY_SCOPE_AGENT) < (unsigned)(2 * DECB)) { __builtin_amdgcn_s_sleep(2); if (++sp > (1u << 22)) break; }
                        __builtin_amdgcn_fence(__ATOMIC_ACQUIRE, "agent"); VM_WAIT(); }
                    __syncthreads(); waited = true; }
                sample_out_unit(lds, su, MIX, WT_OUT, OUTS);
                VM_WAIT(); __syncthreads();
                if (tid == 0) __hip_atomic_fetch_add(ctl + CW_OUTS, 1u, __ATOMIC_RELAXED, __HIP_MEMORY_SCOPE_AGENT);
            }
        }
        for (int u = bid; u < BATCH * NCHUNK; u += G) attn_unit(lds, u / NCHUNK, u % NCHUNK, Qb, KV, SGA, sinks, rel_bias, Qb, !(pre_ok && u == bid));
        {
            if (tid == 0) { unsigned sp = 0; while (__hip_atomic_load(ctl + CW_AGG, __ATOMIC_RELAXED, __HIP_MEMORY_SCOPE_AGENT) < (unsigned)(BATCH * NCHUNK)) { __builtin_amdgcn_s_sleep(2); if (++sp > (1u << 22)) break; }
                __builtin_amdgcn_fence(__ATOMIC_ACQUIRE, "agent"); VM_WAIT(); }
            __syncthreads();
        }
        for (int u = bid; u < BATCH * NCHUNK; u += G) out_unit(lds, u / NCHUNK, u % NCHUNK, (const unsigned*)XB, Qb, AGG, WT_OUT, (const bf16*)(ws + WS_XB2), norm_post, out + O_YP, out);
        if (bid < DECB) {
            if (tid == 0) { unsigned sp = 0; while (__hip_atomic_load(ctl + CW_OUTS, __ATOMIC_RELAXED, __HIP_MEMORY_SCOPE_AGENT) < 64u) { __builtin_amdgcn_s_sleep(2); if (++sp > (1u << 22)) break; } }
            __syncthreads();
            for (int b = bid; b < DECB; b += G) if (wave == 0) {
                const f32x4* r4 = (const f32x4*)(OUTS + (size_t)b * DM) + lane; const f32x4* x4 = (const f32x4*)(x_sample + (size_t)b * DM) + lane; f32x4* y4 = (f32x4*)(out + O_YS + (size_t)b * DM) + lane;
                f32x4 v[4]; float ss = 0.f;
#pragma unroll
                for (int j = 0; j < 4; ++j) { v[j] = __builtin_bit_cast(f32x4, ld16_sc1(r4 + 64 * j)); ss += (v[j].x * v[j].x + v[j].y * v[j].y) + (v[j].z * v[j].z + v[j].w * v[j].w); }
                const float rs = rsqrtf(wave_sum(ss) * (1.0f / DM) + EPS);
#pragma unroll
                for (int j = 0; j < 4; ++j) { const f32x4 gg = ((const f32x4*)norm_post)[lane + 64 * j]; y4[64 * j] = x4[64 * j] + v[j] * rs * gg; }
            }
        }
    }
#undef IN
#undef BOTH
#undef GRID_BAR
}

extern "C" void kernel_launch(void* const* d_in, const int* in_sizes, int n_in, void* d_out, int out_size, void* d_ws, size_t ws_size, hipStream_t stream) {
    static int grid = 0;
    if (grid == 0) {
        int dev = 0, cus = 0;
        if (hipGetDevice(&dev) != hipSuccess || hipDeviceGetAttribute(&cus, hipDeviceAttributeMultiprocessorCount, dev) != hipSuccess) { fprintf(stderr, "kernel_launch: device query failed\n"); grid = -1; return; }
        if (hipFuncSetAttribute((const void*)mk_fwd, hipFuncAttributeMaxDynamicSharedMemorySize, LDS_BYTES) != hipSuccess) { fprintf(stderr, "kernel_launch: hipFuncSetAttribute failed\n"); grid = -1; return; }
        int per_cu = 0;
        if (hipOccupancyMaxActiveBlocksPerMultiprocessor(&per_cu, (const void*)mk_fwd, 512, LDS_BYTES) != hipSuccess || per_cu < 1) { fprintf(stderr, "kernel_launch: occupancy query says %d blocks/CU\n", per_cu); }
        (void)hipGetLastError();
        grid = cus;
    }
    if (grid < 0) return;
    (void)hipMemsetAsync((char*)d_ws + WS_CTL, 0, CTL_ZERO_BYTES, stream);
    Args a{};
    for (int i = 0; i < 19; ++i) a.in[i] = (const float*)d_in[i];
    a.out = (float*)d_out; a.ws = (unsigned char*)d_ws;
    if (MK_N_LAUNCHES == 1) { a.ph_lo = 0; a.ph_hi = N_PHASES; hipLaunchKernelGGL(mk_fwd, dim3(grid), dim3(512), LDS_BYTES, stream, a); }
    else for (int p = 0; p < N_PHASES; ++p) { a.ph_lo = p; a.ph_hi = p + 1; hipLaunchKernelGGL(mk_fwd, dim3(grid), dim3(512), LDS_BYTES, stream, a); }
}
```

```cpp
#include <hip/hip_runtime.h>
#include <cstdint>
#include <cstdio>

namespace pg8 {
__device__ __forceinline__ unsigned cvt_pk_bf16(float lo, float hi) { unsigned r; asm volatile("v_cvt_pk_bf16_f32 %0, %1, %2" : "=v"(r) : "v"(lo), "v"(hi)); return r; }
}

typedef unsigned short bf16;
#define LAS __attribute__((address_space(3)))
#define GAS __attribute__((address_space(1)))
typedef unsigned v4u __attribute__((ext_vector_type(4)));
typedef unsigned v2u __attribute__((ext_vector_type(2)));
typedef float f32x4 __attribute__((ext_vector_type(4)));
typedef short bf16x8 __attribute__((ext_vector_type(8)));
constexpr int DM = 1024, BATCH = 2, SEQ = 8192, DECB = 128;
constexpr int DRNN = 512, DATT = 512, NH = 8, HD = 64, NKV = 2, KVD = 128, WIN = 128, NBUCK = 32;
constexpr int DIN = 2304;
constexpr int MP = BATCH * SEQ;
constexpr int MT = MP + DECB;
constexpr int MPAD = 16640;
constexpr int NCHUNK = SEQ / 64;
constexpr float EPS = 1e-6f;
constexpr float LOG2E = 1.4426950408889634f;
constexpr float QSCALE = 0.125f * LOG2E;

constexpr size_t O_YP = 0, O_YS = O_YP + (size_t)MP * DM, O_CP = O_YS + (size_t)DECB * DM, O_RP = O_CP + 2 * 3 * 512, O_KP = O_RP + 2 * 512,
                 O_VP = O_KP + 2 * 128 * 128, O_CS = O_VP + 2 * 128 * 128, O_RS = O_CS + (size_t)DECB * 3 * 512, O_KS = O_RS + (size_t)DECB * 512,
                 O_VS = O_KS + (size_t)DECB * 128 * 128, O_END = O_VS + (size_t)DECB * 128 * 128;

constexpr size_t MiB = 1u << 20;
constexpr size_t WS_CTL = 0, CTL_ZERO_BYTES = 32768;
constexpr size_t WS_WA = 1 * MiB;
constexpr size_t WS_WB = 3 * MiB;
constexpr size_t WS_WOUT = 6 * MiB;
constexpr size_t WS_WG = 8 * MiB;
constexpr size_t WS_WKV = 8 * MiB + 128 * 1024;
constexpr size_t WS_RSTD = 8 * MiB + 768 * 1024;
constexpr size_t WS_AGG = 9 * MiB;
constexpr size_t WS_XB = 10 * MiB;
constexpr size_t WS_XR = 43 * MiB;
constexpr size_t WS_SGR = 60 * MiB;
constexpr size_t WS_Q = 77 * MiB;
constexpr size_t WS_SGA = 94 * MiB;
constexpr size_t WS_KV = 111 * MiB;
constexpr size_t WS_MIX = 120 * MiB;
constexpr size_t WS_OUTS = 153 * MiB;
constexpr size_t WS_XB2 = 154 * MiB;
constexpr size_t WS_END = 186 * MiB;
constexpr int CW_SMP = 512;
constexpr int CW_AGG = 576;
constexpr int CW_OUTS = 640;
constexpr int CW_BAR = 1024;

constexpr int RING_BYTES = 131072, LDSCTL_OFF = 153600, MISC_OFF = LDSCTL_OFF + 320, LDS_BYTES = 155648;
constexpr int A_STRIDE = 1040;
constexpr int A_ATT = 0, A_RNN = 66560, A_PART = 133120, A_HIN = 135168;
static_assert(A_RNN + 64 * A_STRIDE <= A_PART && A_HIN + 2048 <= LDSCTL_OFF, "lds map");

#define LDS_WAIT() asm volatile("s_waitcnt lgkmcnt(0)" ::: "memory")
#define ST_WT128(ptr, val) asm volatile("global_store_dwordx4 %0, %1, off sc0 sc1\n\ts_nop 1" :: "v"(ptr), "v"(val) : "memory")
#define VM_WAIT() asm volatile("s_waitcnt vmcnt(0)" ::: "memory")
__device__ __forceinline__ float bf2f(bf16 v) { return __uint_as_float((unsigned)v << 16); }
__device__ __forceinline__ unsigned f2bf(float f) { unsigned u = __float_as_uint(f); return (u + 0x7fffu + ((u >> 16) & 1u)) >> 16; }
__device__ __forceinline__ unsigned pk2(float lo, float hi) { return f2bf(lo) | (f2bf(hi) << 16); }
__device__ __forceinline__ float ex2(float x) { return __builtin_amdgcn_exp2f(x); }
__device__ __forceinline__ float rcpf_(float x) { return __builtin_amdgcn_rcpf(x); }
__device__ __forceinline__ float sigmoid_(float x) { return rcpf_(1.0f + ex2(-LOG2E * x)); }
__device__ __forceinline__ float silu_(float x) { return x * sigmoid_(x); }
__device__ __forceinline__ int t5_bucket(int dist) {
    if (dist < 0) dist = 0;
    if (dist < 16) return dist;
    const float d = (float)dist;
    int large = 16 + (int)(logf(d / 16.0f) / 2.0794415416798357f * 16.0f);
    return large < 31 ? large : 31;
}
__device__ __forceinline__ float softplus_neg(float l) { return (l > 0.f) ? log1pf(__expf(-l)) : (-l + log1pf(__expf(l))); }
__device__ __forceinline__ float wave_sum(float v) {
#pragma unroll
    for (int o = 1; o < 64; o <<= 1) v += __shfl_xor(v, o);
    return v;
}


#define XB_TMO      128
#define XB_XCNT(j)  (256  + 64 * (j))
#define XB_XSUB(j)  (1280 + 64 * (j))
#define XB_XGEN(j)  (2304 + 64 * (j))
#define XB_TOP      3328
#define XB_TOPGEN   3392
#define XCD_BAR_WORDS 3456
#define XB_SPIN_CAP (1u << 18)
__device__ __forceinline__ unsigned xb_ld(unsigned* p)              { return __hip_atomic_load(p, __ATOMIC_RELAXED, __HIP_MEMORY_SCOPE_AGENT); }
__device__ __forceinline__ unsigned xb_add(unsigned* p, unsigned v) { return __hip_atomic_fetch_add(p, v, __ATOMIC_RELAXED, __HIP_MEMORY_SCOPE_AGENT); }
__device__ __forceinline__ unsigned xb_xcc_id() { return (unsigned)__builtin_amdgcn_s_getreg((3 << 11) | 20) & 0xFu; }
#define XB_SPIN(cond, bar) do { unsigned _sp = 0; while (cond) { __builtin_amdgcn_s_sleep(1); \
    if ((++_sp & 255u) == 0u) { if (xb_ld(&(bar)[XB_TMO])) break; if (_sp > XB_SPIN_CAP) { atomicAdd(&(bar)[XB_TMO], 1u); break; } } } } while (0)
struct XcdBarrier { unsigned* bar; unsigned x; volatile LAS unsigned* st; };
__device__ __forceinline__ XcdBarrier xcd_barrier_post(unsigned* bar, volatile LAS unsigned* st) {
    XcdBarrier b; b.bar = bar; b.x = xb_xcc_id(); b.st = st;
    if (threadIdx.x == 0) (void)xb_add(&bar[XB_XCNT(b.x)], 1u);
    return b;
}
__device__ __forceinline__ void xcd_barrier_complete(unsigned* bar, unsigned x, unsigned& nloc, unsigned& nx) {
    const unsigned G = gridDim.x * gridDim.y * gridDim.z;
    unsigned sum, cnt, mine, sp = 0u;
    for (;;) {
        sum = 0u; cnt = 0u; mine = 0u;
#pragma unroll
        for (unsigned j = 0; j < 16; ++j) { const unsigned c = xb_ld(&bar[XB_XCNT(j)]); sum += c; cnt += (c > 0u) ? 1u : 0u; mine = (j == x) ? c : mine; }
        if (sum == G) break;
        __builtin_amdgcn_s_sleep(1);
        if ((++sp & 255u) == 0u) { if (xb_ld(&bar[XB_TMO])) break; if (sp > XB_SPIN_CAP) { atomicAdd(&bar[XB_TMO], 1u); break; } }
    }
    nloc = mine > 0u ? mine : 1u; nx = cnt > 0u ? cnt : 1u;
}
__device__ __forceinline__ void xcd_barrier(const XcdBarrier& b) {
    asm volatile("s_waitcnt vmcnt(0)" ::: "memory");
    __syncthreads();
    if (threadIdx.x == 0) {
        unsigned* bar = b.bar;
        __builtin_amdgcn_s_waitcnt(0);
        unsigned nloc = b.st[0], nx = b.st[1];
        if (nloc == 0u) { xcd_barrier_complete(bar, b.x, nloc, nx); b.st[0] = nloc; b.st[1] = nx; }
        const unsigned old = xb_add(&bar[XB_XSUB(b.x)], 1u);
        const unsigned gen = old / nloc;
        if (old + 1u == (gen + 1u) * nloc) {
            __builtin_amdgcn_fence(__ATOMIC_RELEASE, "agent");
            asm volatile("s_waitcnt vmcnt(0)" ::: "memory");
            const unsigned og = xb_add(&bar[XB_TOP], 1u);
            const unsigned tg = og / nx;
            if (og + 1u == (tg + 1u) * nx) xb_add(&bar[XB_TOPGEN], 1u);
            else XB_SPIN(xb_ld(&bar[XB_TOPGEN]) == tg, bar);
            __builtin_amdgcn_fence(__ATOMIC_ACQUIRE, "agent");
            xb_add(&bar[XB_XGEN(b.x)], 1u);
            asm volatile("s_waitcnt vmcnt(0)" ::: "memory");
        } else {
            __builtin_amdgcn_fence(__ATOMIC_ACQUIRE, "agent");
            asm volatile("s_waitcnt vmcnt(0)" ::: "memory");
            XB_SPIN(xb_ld(&bar[XB_XGEN(b.x)]) == gen, bar);
        }
    }
    __syncthreads();
}

template <int MODE>
__device__ __forceinline__ void p0_transpose_item(const float* W, int K, int N, bf16* WT, const float* kscale, LAS float* scr, int item, int lane, int dst_n0, float gscale = 1.0f) {
    const int nblk = N / 32, kb = item / nblk, nb = item % nblk, k0 = 64 * kb, n0 = 32 * nb;
    {   float wv[32], sv[32];
#pragma unroll
        for (int i = 0; i < 32; ++i) { const int kk = 2 * i + (lane >> 5); wv[i] = __builtin_nontemporal_load(W + (size_t)(k0 + kk) * N + n0 + (lane & 31)); sv[i] = kscale ? kscale[k0 + kk] : 1.0f; }
        __builtin_amdgcn_sched_barrier(0);
#pragma unroll
        for (int i = 0; i < 32; ++i) { const int kk = 2 * i + (lane >> 5); scr[kk * 33 + (lane & 31)] = wv[i] * sv[i] * gscale; }
    }
    LDS_WAIT(); asm volatile("" ::: "memory");
    const int c = lane & 7;
#pragma unroll
    for (int j = 0; j < 4; ++j) { const int n = (lane >> 3) + 8 * j; const LAS float* sp = scr + (8 * c) * 33 + n;
        v4u o; o.x = pk2(sp[0 * 33], sp[1 * 33]); o.y = pk2(sp[2 * 33], sp[3 * 33]); o.z = pk2(sp[4 * 33], sp[5 * 33]); o.w = pk2(sp[6 * 33], sp[7 * 33]);
        const int nn = dst_n0 + n, kk = k0 + 8 * c;
        if (MODE == 3 || MODE == 4) {
            const int NTT = MODE == 3 ? 8 : 2, slab = MODE == 3 ? nn >> 7 : nn >> 5, cw = MODE == 3 ? nn & 127 : nn & 31, rem = cw & 31;
            const int nt = 2 * (cw >> 5) + ((rem >> 2) & 1), ln = 4 * (rem >> 3) + (rem & 3);
            { bf16* wp_ = WT + ((size_t)(((slab * 32 + (kk >> 5)) * NTT + nt) * 64 + (((kk >> 3) & 3) * 16 + ln))) * 8; ST_WT128(wp_, o); } }
        else if (MODE == 1) { bf16* wp_ = WT + ((size_t)((((nn >> 7) * 32 + (kk >> 5)) * 8 + ((nn >> 4) & 7)) * 64 + (((kk >> 3) & 3) * 16 + (nn & 15)))) * 8; ST_WT128(wp_, o); }
        else if (MODE == 2) *(v4u*)(WT + ((size_t)((((nn >> 5) * 32 + (kk >> 5)) * 2 + ((nn >> 4) & 1)) * 64 + (((kk >> 3) & 3) * 16 + (nn & 15)))) * 8) = o;
        else { bf16* wp_ = WT + (size_t)nn * K + kk; ST_WT128(wp_, o); } }
    LDS_WAIT(); asm volatile("" ::: "memory");
}
template <int NR>
__device__ __forceinline__ void p0_rows(const float* const (&xrow)[NR], bf16* const (&orow)[NR], float* const (&rs)[NR], int lane) {
    f32x4 v[NR][4];
#pragma unroll
    for (int r = 0; r < NR; ++r)
#pragma unroll
        for (int j = 0; j < 4; ++j) v[r][j] = ((const f32x4*)xrow[r])[lane + 64 * j];
    __builtin_amdgcn_sched_barrier(0);
#pragma unroll
    for (int r = 0; r < NR; ++r) { float s = 0.f;
#pragma unroll
        for (int j = 0; j < 4; ++j) s += (v[r][j].x * v[r][j].x + v[r][j].y * v[r][j].y) + (v[r][j].z * v[r][j].z + v[r][j].w * v[r][j].w);
        s = wave_sum(s);
        if (lane == 0) __hip_atomic_store(rs[r], rsqrtf(s * (1.0f / DM) + EPS), __ATOMIC_RELAXED, __HIP_MEMORY_SCOPE_AGENT);
        unsigned long long* o8 = (unsigned long long*)orow[r] + lane;
#pragma unroll
        for (int j = 0; j < 4; ++j) __hip_atomic_store(o8 + 64 * j, (unsigned long long)pk2(v[r][j].x, v[r][j].y) | ((unsigned long long)pk2(v[r][j].z, v[r][j].w) << 32), __ATOMIC_RELAXED, __HIP_MEMORY_SCOPE_AGENT); }
}

typedef _Float16 f16;
struct RgArgs { const bf16* XR; const bf16* SGR; const bf16* WG; const float* conv_w; const float* conv_b; const float* b_a; const float* b_x; const float* lam; float* AGG; unsigned* UV; };
constexpr int XCB_STRIDE = 1040;
constexpr int ZS = 516;
constexpr int RG_XCB = 0, RG_ZR = 16 * XCB_STRIDE, RG_ZI = RG_ZR + 16 * ZS * 4, RG_LDS = RG_ZI + 16 * ZS * 4;
static_assert(RG_LDS <= 100 * 1024, "rg lds");
__device__ __forceinline__ void rglru_unit(LAS unsigned char* lds, const RgArgs& R, int b, int c) {
    int tid = threadIdx.x; asm volatile("" : "+v"(tid));
    const int ch = tid, lane = tid & 63, w = __builtin_amdgcn_readfirstlane(tid >> 6);
    const size_t row0 = (size_t)b * SEQ + 64 * c;
    bf16x8 bw[2][4][2];
#pragma unroll
    for (int g = 0; g < 2; ++g)
#pragma unroll
        for (int nt = 0; nt < 4; ++nt)
#pragma unroll
            for (int ks = 0; ks < 2; ++ks) bw[g][nt][ks] = *(const bf16x8*)(R.WG + ((size_t)((w * 2 + g) * 64 + nt * 16 + (lane & 15))) * 64 + ks * 32 + 8 * (lane >> 4));
    const float cb = R.conv_b[ch], w0 = R.conv_w[ch], w1 = R.conv_w[512 + ch], w2 = R.conv_w[1024 + ch], w3 = R.conv_w[1536 + ch];
    const float ba = -LOG2E * R.b_a[ch], bxb = -LOG2E * R.b_x[ch];
    const float c2 = -8.0f * softplus_neg(R.lam[ch]) * LOG2E;
    float h = 0.f, acum = 1.0f;
    const bf16* xp = R.XR + row0 * 512 + ch;
    float xm3 = 0.f, xm2 = 0.f, xm1 = 0.f;
    if (c > 0) { xm3 = bf2f(xp[-3 * 512]); xm2 = bf2f(xp[-2 * 512]); xm1 = bf2f(xp[-1 * 512]); }
    unsigned xs[16], sg[16];
    const bf16* sp = R.SGR + row0 * 512 + ch;
#pragma unroll
    for (int i = 0; i < 16; ++i) { xs[i] = xp[i * 512]; sg[i] = sp[i * 512]; }
    __builtin_amdgcn_sched_barrier(0);
    LAS unsigned char* xcb = lds + RG_XCB; LAS float* zr = (LAS float*)(lds + RG_ZR); LAS float* zi = (LAS float*)(lds + RG_ZI);
    unsigned* uvp = R.UV + row0 * 512 + ch;
#pragma unroll 1
    for (int s = 0; s < 4; ++s) {
        unsigned xn[16], sn[16];
        { const int s1 = s < 3 ? s + 1 : 3;
#pragma unroll
            for (int i = 0; i < 16; ++i) { xn[i] = xp[(16 * s1 + i) * 512]; sn[i] = sp[(16 * s1 + i) * 512]; } }
        float xc[16];
#pragma unroll
        for (int i = 0; i < 16; ++i) { const float x = __uint_as_float(xs[i] << 16); xc[i] = cb + w0 * xm3 + w1 * xm2 + w2 * xm1 + w3 * x; xm3 = xm2; xm2 = xm1; xm1 = x;
            *(LAS bf16*)(xcb + i * XCB_STRIDE + ch * 2) = (bf16)pg8::cvt_pk_bf16(xc[i], 0.f); }
        LDS_WAIT(); __builtin_amdgcn_wave_barrier();
        {
            bf16x8 af[2];
#pragma unroll
            for (int ks = 0; ks < 2; ++ks) af[ks] = *(const LAS bf16x8*)(xcb + (lane & 15) * XCB_STRIDE + (64 * w + 32 * ks + 8 * (lane >> 4)) * 2);
#pragma unroll
            for (int g = 0; g < 2; ++g)
#pragma unroll
                for (int nt = 0; nt < 4; ++nt) { f32x4 acc = {0.f, 0.f, 0.f, 0.f};
#pragma unroll
                    for (int ks = 0; ks < 2; ++ks) acc = __builtin_amdgcn_mfma_f32_16x16x32_bf16(af[ks], bw[g][nt][ks], acc, 0, 0, 0);
                    LAS float* z = g ? zi : zr;
#pragma unroll
                    for (int r = 0; r < 4; ++r) z[(4 * (lane >> 4) + r) * ZS + 64 * w + 16 * nt + (lane & 15)] = acc[r]; }
        }
        LDS_WAIT(); __builtin_amdgcn_wave_barrier();
        typedef float f32x2 __attribute__((ext_vector_type(2)));
#pragma unroll
        for (int i = 0; i < 16; i += 2) {
            const f32x2 zrv = {zr[i * ZS + ch], zr[(i + 1) * ZS + ch]}, ziv = {zi[i * ZS + ch], zi[(i + 1) * ZS + ch]};
            const f32x2 er = zrv + ba, ei = ziv + bxb;
            f32x2 dr = {ex2(er.x), ex2(er.y)}, di = {ex2(ei.x), ex2(ei.y)};
            dr = dr + 1.0f; di = di + 1.0f;
            const f32x2 r = {rcpf_(dr.x), rcpf_(dr.y)}, ig = {rcpf_(di.x), rcpf_(di.y)};
            const f32x2 l2 = r * c2;
            const f32x2 a = {ex2(l2.x), ex2(l2.y)};
            const f32x2 x2 = l2 * 1.3862943611198906f;
            const f32x2 em_small = -x2 * ((x2 * 0.16666667f + 0.5f) * x2 + 1.0f);
            const f32x2 em_big = 1.0f - a * a;
            const f32x2 em = {(x2.x > -0.015625f) ? em_small.x : em_big.x, (x2.y > -0.015625f) ? em_small.y : em_big.y};
            const f32x2 sq = {__builtin_amdgcn_sqrtf(em.x), __builtin_amdgcn_sqrtf(em.y)};
            const f32x2 xcv = {xc[i], xc[i + 1]};
            const f32x2 bx = sq * (ig * xcv);
            const float h0 = __builtin_fmaf(a.x, h, bx.x), h1 = __builtin_fmaf(a.y, h0, bx.y);
            const float ac0 = acum * a.x, ac1 = ac0 * a.y;
            h = h1; acum = ac1;
            const f32x2 sgv = {__uint_as_float(sg[i] << 16), __uint_as_float(sg[i + 1] << 16)};
            const f32x2 uu = sgv * (f32x2){h0, h1}, vv2 = sgv * (f32x2){ac0, ac1};
            typedef f16 f16x2 __attribute__((ext_vector_type(2)));
            const f16x2 p0 = {(f16)uu.x, (f16)vv2.x}, p1 = {(f16)uu.y, (f16)vv2.y};
            uvp[(size_t)(16 * s + i) * 512] = __builtin_bit_cast(unsigned, p0);
            uvp[(size_t)(16 * s + i + 1) * 512] = __builtin_bit_cast(unsigned, p1);
        }
#pragma unroll
        for (int i = 0; i < 16; ++i) { xs[i] = xn[i]; sg[i] = sn[i]; }
    }
    { float* ag = R.AGG + ((size_t)b * NCHUNK + c) * 1024 + ch;
      __hip_atomic_store(ag, acum, __ATOMIC_RELAXED, __HIP_MEMORY_SCOPE_AGENT); __hip_atomic_store(ag + 512, h, __ATOMIC_RELAXED, __HIP_MEMORY_SCOPE_AGENT); }
    VM_WAIT(); __syncthreads();
}

typedef float f32x16 __attribute__((ext_vector_type(16)));
constexpr int AT_K = 0, AT_KS = 144, AT_NK = 192, AT_VT = 2 * AT_NK * AT_KS, AT_VS = 392, AT_T = AT_VT + 2 * 64 * AT_VS, AT_LDS = AT_T + 8 * 384 * 4;
static_assert(AT_LDS <= 144384, "attention lds");
__device__ __forceinline__ unsigned cvtpk(float lo, float hi) { unsigned r; asm volatile("v_cvt_pk_bf16_f32 %0, %1, %2" : "=v"(r) : "v"(lo), "v"(hi)); return r; }
__device__ __forceinline__ void attn_table(LAS unsigned char* lds, const float* rel_bias) {
    LAS float* T = (LAS float*)(lds + AT_T);
    for (int e = threadIdx.x; e < 8 * 384; e += 512) { const int hl = e / 384, ti = e - hl * 384; float v = -1e30f; if (ti >= 128 && ti <= 255) v = rel_bias[t5_bucket(255 - ti) * NH + hl] * LOG2E; T[e] = v; }
}
__device__ __forceinline__ void attn_unit(LAS unsigned char* lds, int b, int c, const bf16* Q, const bf16* KV, const bf16* SGA, const float* sinks, const float* rel_bias, bf16* MIX, bool build_T, bool to_lds) {
    int tid = threadIdx.x; asm volatile("" : "+v"(tid));
    const int lane = tid & 63, w = __builtin_amdgcn_readfirstlane(tid >> 6), r32 = lane & 31, hi = lane >> 5;
    const int n = c >> 1, half = c & 1, kt0 = 2 * half, h = w, g = w >> 2;
    const size_t rowblk = (size_t)b * SEQ + 128 * n;
    LAS float* T = (LAS float*)(lds + AT_T);
    {   v4u kk[6], vv[6];
#pragma unroll
        for (int i = 0; i < 6; ++i) { const int e = tid + 512 * i, key = e >> 4, gq = (e >> 3) & 1, cc = e & 7;
            const int kb = 32 * kt0 + key;
            const int ksrc = (n > 0 || kb >= 128) ? kb : kb + 128;
            const bf16* kr = KV + (rowblk - 128 + ksrc) * 256 + gq * 64 + cc * 8;
            kk[i] = *(const v4u*)kr; vv[i] = *(const v4u*)(kr + 128); }
        __builtin_amdgcn_sched_barrier(0);
#pragma unroll
        for (int i = 0; i < 6; ++i) { const int e = tid + 512 * i, key = e >> 4, gq = (e >> 3) & 1, cc = e & 7;
            *(LAS v4u*)(lds + AT_K + (gq * AT_NK + key) * AT_KS + cc * 16) = kk[i];
#pragma unroll
            for (int j = 0; j < 8; ++j) *(LAS bf16*)(lds + AT_VT + (gq * 64 + cc * 8 + j) * AT_VS + key * 2) = (bf16)((vv[i][j >> 1] >> (16 * (j & 1))) & 0xffffu); }
    }
    if (build_T) attn_table(lds, rel_bias);
    LDS_WAIT(); __syncthreads();
    const float sinkv = sinks[h] * LOG2E;
    v2u ovs[2][4];
#pragma unroll 1
    for (int i = 0; i < 2; ++i) {
        const int qt = kt0 + i; const size_t qrow = rowblk + 32 * qt + r32;
        bf16x8 qf[4];
#pragma unroll
        for (int ks = 0; ks < 4; ++ks) qf[ks] = *(const bf16x8*)(Q + qrow * 512 + h * 64 + 16 * ks + 8 * hi);
        v2u sgv[2][4];
#pragma unroll
        for (int dt = 0; dt < 2; ++dt)
#pragma unroll
            for (int i4 = 0; i4 < 4; ++i4) sgv[dt][i4] = *(const v2u*)(SGA + qrow * 512 + h * 64 + 32 * dt + 8 * i4 + 4 * hi);
        f32x16 s[5];
#pragma unroll
        for (int j = 0; j < 5; ++j) {
            const int kt = qt + j, ktl = i + j;
            if (n == 0 && kt < 4) {
#pragma unroll
                for (int r = 0; r < 16; ++r) s[j][r] = -1e30f;
            } else {
                const LAS float* tp = T + h * 384 + (32 * kt + 4 * hi - 32 * qt - r32 + 127);
#pragma unroll
                for (int r = 0; r < 16; ++r) s[j][r] = tp[(r & 3) + 8 * (r >> 2)];
                const LAS unsigned char* kp = lds + AT_K + (g * AT_NK + 32 * ktl + r32) * AT_KS + 16 * hi;
#pragma unroll
                for (int ks = 0; ks < 4; ++ks) { const bf16x8 kf = *(const LAS bf16x8*)(kp + 32 * ks); s[j] = __builtin_amdgcn_mfma_f32_32x32x16_bf16(kf, qf[ks], s[j], 0, 0, 0); }
            }
        }
        float m = sinkv;
#pragma unroll
        for (int j = 0; j < 5; ++j)
#pragma unroll
            for (int r = 0; r < 16; ++r) m = fmaxf(m, s[j][r]);
        { auto rr = __builtin_amdgcn_permlane32_swap(__float_as_uint(m), __float_as_uint(m), false, false); m = fmaxf(__uint_as_float(rr[0]), __uint_as_float(rr[1])); }
        float l = 0.f;
#pragma unroll
        for (int j = 0; j < 5; ++j)
#pragma unroll
            for (int r = 0; r < 16; ++r) { const float p = ex2(s[j][r] - m); s[j][r] = p; l += p; }
        { auto rr = __builtin_amdgcn_permlane32_swap(__float_as_uint(l), __float_as_uint(l), false, false); l = __uint_as_float(rr[0]) + __uint_as_float(rr[1]); }
        l += ex2(sinkv - m);
        f32x16 o[2];
#pragma unroll
        for (int r = 0; r < 16; ++r) { o[0][r] = 0.f; o[1][r] = 0.f; }
#pragma unroll
        for (int j = 0; j < 5; ++j) {
            const int kt = qt + j, ktl = i + j;
            if (!(n == 0 && kt < 4)) {
#pragma unroll
                for (int s2 = 0; s2 < 2; ++s2) {
                    v4u pw; pw.x = cvtpk(s[j][8 * s2 + 0], s[j][8 * s2 + 1]); pw.y = cvtpk(s[j][8 * s2 + 2], s[j][8 * s2 + 3]); pw.z = cvtpk(s[j][8 * s2 + 4], s[j][8 * s2 + 5]); pw.w = cvtpk(s[j][8 * s2 + 6], s[j][8 * s2 + 7]);
                    const bf16x8 pf = __builtin_bit_cast(bf16x8, pw);
#pragma unroll
                    for (int dt = 0; dt < 2; ++dt) {
                        const LAS unsigned char* vp = lds + AT_VT + (g * 64 + 32 * dt + r32) * AT_VS + (32 * ktl + 16 * s2 + 4 * hi) * 2;
                        const v2u vlo = *(const LAS v2u*)vp, vhi = *(const LAS v2u*)(vp + 16);
                        v4u vw; vw.x = vlo.x; vw.y = vlo.y; vw.z = vhi.x; vw.w = vhi.y;
                        o[dt] = __builtin_amdgcn_mfma_f32_32x32x16_bf16(__builtin_bit_cast(bf16x8, vw), pf, o[dt], 0, 0, 0);
                    }
                }
            }
        }
        const float il = 1.0f / l;
#pragma unroll
        for (int dt = 0; dt < 2; ++dt)
#pragma unroll
            for (int i4 = 0; i4 < 4; ++i4) { const int d0 = 32 * dt + 8 * i4 + 4 * hi; const v2u sg = sgv[dt][i4];
                const float a0 = o[dt][4 * i4 + 0] * il * __uint_as_float(sg.x << 16), a1 = o[dt][4 * i4 + 1] * il * __uint_as_float(sg.x & 0xffff0000u);
                const float a2 = o[dt][4 * i4 + 2] * il * __uint_as_float(sg.y << 16), a3 = o[dt][4 * i4 + 3] * il * __uint_as_float(sg.y & 0xffff0000u);
                v2u ov; ov.x = cvtpk(a0, a1); ov.y = cvtpk(a2, a3);
                ovs[dt][i4] = ov;
                if (!to_lds) *(v2u*)(MIX + qrow * 512 + h * 64 + d0) = ov;
                else if (i == 0) *(LAS v2u*)(lds + AT_LDS + r32 * A_STRIDE + (h * 64 + d0) * 2) = ov; }
    }
    __syncthreads();
    if (to_lds) {
#pragma unroll
        for (int dt = 0; dt < 2; ++dt)
#pragma unroll
            for (int i4 = 0; i4 < 4; ++i4) *(LAS v2u*)(lds + A_ATT + (32 + r32) * A_STRIDE + (h * 64 + 32 * dt + 8 * i4 + 4 * hi) * 2) = ovs[dt][i4];
#pragma unroll
        for (int i = 0; i < 4; ++i) { const int e = tid + 512 * i, r = e >> 6, cc = e & 63;
            *(LAS v4u*)(lds + A_ATT + r * A_STRIDE + cc * 16) = *(const LAS v4u*)(lds + AT_LDS + r * A_STRIDE + cc * 16); }
        LDS_WAIT(); __syncthreads();
    }
}

struct SmpArgs { const bf16 *XR, *SGR, *Q, *KV, *SGA, *WG; const float *state_conv, *state_rnn, *ck, *cv, *conv_w, *conv_b, *b_a, *b_x, *lam, *sinks; bf16* MIX; float* out; };
constexpr int SM_XC = 0, SM_QS = 1024, SM_PS = 2048, SM_XB = 4096, SM_ZS = 4608, SM_KS = 8192, SM_VS = SM_KS + 128 * 65 * 4, SM_LDS = SM_VS + 128 * 64 * 4;
constexpr int BTAB_OFF = 144384;
static_assert(SM_ZS + 2048 <= SM_KS && SM_LDS <= BTAB_OFF && BTAB_OFF + 4096 <= LDSCTL_OFF, "sample lds");
__device__ __forceinline__ void st_wt16(bf16* p, unsigned v) { __hip_atomic_store(p, (bf16)v, __ATOMIC_RELAXED, __HIP_MEMORY_SCOPE_AGENT); }
struct SmpPre { f32x4 kk[4], vv[4]; };
__device__ __forceinline__ void sample_prefetch(SmpPre& p, const float* ck, const float* cv, int b, int g, int tid) {
    const float* ckb = ck + (size_t)b * 16384 + 128 + g * 64; const float* cvb = cv + (size_t)b * 16384 + 128 + g * 64;
#pragma unroll
    for (int i = 0; i < 4; ++i) { const int e0 = tid + 512 * i, e = e0 < 127 * 16 ? e0 : 127 * 16 - 1; const int ww = e >> 4, d = (e & 15) * 4; p.kk[i] = __builtin_nontemporal_load((const f32x4*)(ckb + ww * 128 + d)); p.vv[i] = __builtin_nontemporal_load((const f32x4*)(cvb + ww * 128 + d)); }
}
template <bool PRE>
__device__ __forceinline__ void sample_unit(LAS unsigned char* lds, const LAS float* btab, const SmpArgs& S, int b, int g, unsigned* cnt, const SmpPre& pre) {
    LAS float* xc = (LAS float*)(lds + SM_XC); LAS float* qs = (LAS float*)(lds + SM_QS); LAS float* ps = (LAS float*)(lds + SM_PS); LAS float* Ks = (LAS float*)(lds + SM_KS); LAS float* Vs = (LAS float*)(lds + SM_VS);
    LAS float* zs = (LAS float*)(lds + SM_ZS);
    int tid = threadIdx.x; asm volatile("" : "+v"(tid));
    const int lane = tid & 63, w = __builtin_amdgcn_readfirstlane(tid >> 6);
    const size_t r = (size_t)(MP + b);
    const int t8 = tid & 255, ch = 256 * g + t8;
    const float* ckb = S.ck + (size_t)b * 16384 + 128 + g * 64; const float* cvb = S.cv + (size_t)b * 16384 + 128 + g * 64;
    f32x4 kk[4], vv[4];
    if (PRE) {
#pragma unroll
        for (int i = 0; i < 4; ++i) { kk[i] = pre.kk[i]; vv[i] = pre.vv[i]; }
    } else {
#pragma unroll
        for (int i = 0; i < 4; ++i) { const int e0 = tid + 512 * i, e = e0 < 127 * 16 ? e0 : 127 * 16 - 1; const int ww = e >> 4, d = (e & 15) * 4; kk[i] = __builtin_nontemporal_load((const f32x4*)(ckb + ww * 128 + d)); vv[i] = __builtin_nontemporal_load((const f32x4*)(cvb + ww * 128 + d)); }
    }
    const unsigned x0u = S.XR[r * 512 + ch], qu = S.Q[r * 512 + ch], sgru = S.SGR[r * 512 + ch], sgau = S.SGA[r * 512 + ch];
    const unsigned knu = S.KV[r * 256 + g * 64 + (tid & 63)], vnu = S.KV[r * 256 + 128 + g * 64 + (tid & 63)];
    const float s0 = S.state_conv[(size_t)(b * 3 + 0) * 512 + ch], s1 = S.state_conv[(size_t)(b * 3 + 1) * 512 + ch], s2 = S.state_conv[(size_t)(b * 3 + 2) * 512 + ch];
    const float cw0 = S.conv_w[ch], cw1 = S.conv_w[512 + ch], cw2 = S.conv_w[1024 + ch], cw3 = S.conv_w[1536 + ch], cbv = S.conv_b[ch];
    const float bav = S.b_a[ch], bxv = S.b_x[ch], lamv = S.lam[ch], h0 = S.state_rnn[(size_t)b * 512 + ch];
    const float skv = S.sinks[4 * g + (w & 3)];
    bf16x8 bw[2][4][2];
    { const int nb = 4 * g + (w & 3);
#pragma unroll
      for (int gg = 0; gg < 2; ++gg)
#pragma unroll
        for (int nt = 0; nt < 4; ++nt)
#pragma unroll
            for (int ks = 0; ks < 2; ++ks) bw[gg][nt][ks] = *(const bf16x8*)(S.WG + ((size_t)((nb * 2 + gg) * 64 + nt * 16 + (lane & 15))) * 64 + ks * 32 + 8 * (lane >> 4)); }
    __builtin_amdgcn_sched_barrier(0);
    const float x0 = __uint_as_float(x0u << 16);
    const float xcv = cbv + cw0 * s0 + cw1 * s1 + cw2 * s2 + cw3 * x0;
    if (tid < 256) { xc[t8] = xcv; *(LAS bf16*)(lds + SM_XB + t8 * 2) = (bf16)pg8::cvt_pk_bf16(xcv, 0.f); qs[t8] = __uint_as_float(qu << 16);
        S.out[O_CS + (size_t)(b * 3 + 0) * 512 + ch] = s1; S.out[O_CS + (size_t)(b * 3 + 1) * 512 + ch] = s2; }
    else if (tid < 320) { Ks[127 * 65 + lane] = __uint_as_float(knu << 16); Vs[127 * 64 + lane] = __uint_as_float(vnu << 16); }
#pragma unroll
    for (int i = 0; i < 4; ++i) { const int e = tid + 512 * i; if (e < 127 * 16) { const int ww = e >> 4, d = (e & 15) * 4;
        LAS float* kd = Ks + ww * 65 + d; kd[0] = kk[i].x; kd[1] = kk[i].y; kd[2] = kk[i].z; kd[3] = kk[i].w; *(LAS f32x4*)(Vs + ww * 64 + d) = vv[i]; } }
    __syncthreads();    if (tid < 256) {
        bf16x8 af[2];
#pragma unroll
        for (int ks = 0; ks < 2; ++ks) af[ks] = *(const LAS bf16x8*)(lds + SM_XB + (64 * w + 32 * ks + 8 * (lane >> 4)) * 2);
#pragma unroll
        for (int gg = 0; gg < 2; ++gg)
#pragma unroll
            for (int nt = 0; nt < 4; ++nt) { f32x4 acc = {0.f, 0.f, 0.f, 0.f};
#pragma unroll
                for (int ks = 0; ks < 2; ++ks) acc = __builtin_amdgcn_mfma_f32_16x16x32_bf16(af[ks], bw[gg][nt][ks], acc, 0, 0, 0);
                if (lane < 16) zs[gg * 256 + 64 * w + 16 * nt + lane] = acc[0]; }
        LDS_WAIT(); __builtin_amdgcn_wave_barrier();
        const float rr = rcpf_(1.0f + ex2(zs[t8] - LOG2E * bav)), ig = rcpf_(1.0f + ex2(zs[256 + t8] - LOG2E * bxv));
        const float l2 = rr * (-8.0f * softplus_neg(lamv) * LOG2E); const float a = ex2(l2);
        const float x2 = 1.3862943611198906f * l2;
        const float em_small = -x2 * __builtin_fmaf(__builtin_fmaf(x2, 0.16666667f, 0.5f), x2, 1.0f);
        const float em = (x2 > -0.015625f) ? em_small : __builtin_fmaf(-a, a, 1.0f);
        const float h = a * h0 + __builtin_amdgcn_sqrtf(em) * (ig * xcv);
        S.out[O_RS + (size_t)b * 512 + ch] = h;
        st_wt16(S.MIX + r * DM + ch, pg8::cvt_pk_bf16(h * __uint_as_float(sgru << 16), 0.f));
    }
    {
        const int hh = tid >> 7, ww = tid & 127;
        const LAS float* kp = Ks + ww * 65; const LAS float* qp = qs + hh * 64;
        float sc = 0.f;
#pragma unroll 16
        for (int d = 0; d < 64; ++d) sc += qp[d] * kp[d];
        ps[hh * 128 + ww] = sc + btab[(4 * g + hh) * 128 + 127 - ww];
    }
    __syncthreads();    if (tid < 256) {
        const float sa = ps[w * 128 + lane], sb = ps[w * 128 + 64 + lane];
        const float sk = skv * LOG2E;
        float m = fmaxf(fmaxf(sa, sb), sk);
#pragma unroll
        for (int o2 = 32; o2 > 0; o2 >>= 1) m = fmaxf(m, __shfl_xor(m, o2));
        const float p0 = ex2(sa - m), p1 = ex2(sb - m);
        const float l = wave_sum(p0 + p1) + ex2(sk - m);
        const float il = 1.0f / l;
        ps[w * 128 + lane] = p0 * il; ps[w * 128 + 64 + lane] = p1 * il;
        LDS_WAIT(); __builtin_amdgcn_wave_barrier();
        const LAS float* vp = Vs + lane; const LAS float* pp = ps + w * 128;
        float o = 0.f;
#pragma unroll 16
        for (int k = 0; k < 128; ++k) o += pp[k] * vp[k * 64];
        st_wt16(S.MIX + r * DM + 512 + ch, pg8::cvt_pk_bf16(o * __uint_as_float(sgau << 16), 0.f));
    }
    VM_WAIT(); __syncthreads();    if (tid == 0) __hip_atomic_fetch_add(cnt, 1u, __ATOMIC_RELAXED, __HIP_MEMORY_SCOPE_AGENT);
    {
        float* okb = S.out + O_KS + (size_t)b * 16384 + g * 64; float* ovb = S.out + O_VS + (size_t)b * 16384 + g * 64;
#pragma unroll
        for (int i = 0; i < 4; ++i) { const int e = tid + 512 * i; if (e < 127 * 16) { const int ww = e >> 4, d = (e & 15) * 4; __builtin_nontemporal_store(kk[i], (f32x4*)(okb + ww * 128 + d)); __builtin_nontemporal_store(vv[i], (f32x4*)(ovb + ww * 128 + d)); } }
    }
}

template <int NLOADS>
__device__ __forceinline__ unsigned l2_warm_issue(v4u (&pf)[NLOADS], const void* base, int tid) {
    const char* p = (const char*)base + ((size_t)(((blockIdx.x >> 3) & 31) * 8 + (tid >> 6)) * NLOADS) * 1024 + (tid & 63) * 16;
#pragma unroll
    for (int i = 0; i < NLOADS; ++i) pf[i] = *(const v4u*)(p + i * 1024);
    return 0u;
}
template <int NLOADS>
__device__ __forceinline__ void l2_warm_retire(const v4u (&pf)[NLOADS], unsigned* sink) {
    unsigned a = 0u;
#pragma unroll
    for (int i = 0; i < NLOADS; ++i) a |= pf[i].x ^ pf[i].y ^ pf[i].z ^ pf[i].w;
    if (a == 0x9E3779B9u && threadIdx.x == 12345) *sink = a;
}
constexpr int A_LO = A_RNN, A_HI = A_ATT, A_RS = A_PART;
struct ProjArgs { const float* x; const bf16 *WA, *WB, *WKV; bf16 *XR, *SGR, *Q, *SGA, *KV; float* out; unsigned* sink; bf16* XB2; };
#define AS_LOADB(dst, wfp, NTT, ks) do { _Pragma("unroll") for (int nt = 0; nt < NTT; ++nt) dst[nt] = *(const bf16x8*)((wfp) + (size_t)(((ks) * NTT + nt) * 512)); } while (0)
#define AS_STEP(accv, bw, NTT, ks) do { bf16x8 af[4]; const LAS unsigned char* ap = abase + (((ks) < 16) ? A_LO : A_HI) + (((ks) & 15) * 64); \
        _Pragma("unroll") for (int mt = 0; mt < 4; ++mt) af[mt] = *(const LAS bf16x8*)(ap + mt * 16 * A_STRIDE); \
        _Pragma("unroll") for (int mt = 0; mt < 4; ++mt) _Pragma("unroll") for (int nt = 0; nt < NTT; ++nt) accv[mt][nt] = __builtin_amdgcn_mfma_f32_16x16x32_bf16(bw[nt], af[mt], accv[mt][nt], 0, 0, 0); } while (0)
__device__ __forceinline__ v4u pack8(f32x4 a, f32x4 b) { v4u o; o.x = pg8::cvt_pk_bf16(a.x, a.y); o.y = pg8::cvt_pk_bf16(a.z, a.w); o.z = pg8::cvt_pk_bf16(b.x, b.y); o.w = pg8::cvt_pk_bf16(b.z, b.w); return o; }
__device__ __forceinline__ f32x4 silu4(f32x4 v) { f32x4 o; o.x = silu_(v.x); o.y = silu_(v.y); o.z = silu_(v.z); o.w = silu_(v.w); return o; }
template <int PASS>
__device__ __forceinline__ void proj_pass(const LAS unsigned char* abase, size_t row0, int w, int lane, int fr, int fq, const float (&rs)[4], const bf16* W, bf16* dlo, bf16* dhi, float* out) {
    const bf16* wf = W + (size_t)w * (32 * 8 * 64 * 8) + lane * 8;
    f32x4 acc[4][8];
#pragma unroll
    for (int mt = 0; mt < 4; ++mt)
#pragma unroll
        for (int nt = 0; nt < 8; ++nt) acc[mt][nt] = (f32x4){0.f, 0.f, 0.f, 0.f};
    bf16x8 b0[8], b1[8], b2[8];
    AS_LOADB(b0, wf, 8, 0); AS_LOADB(b1, wf, 8, 1);
#pragma unroll 1
    for (int ks = 0; ks < 30; ks += 3) {
        AS_LOADB(b2, wf, 8, ks + 2); __builtin_amdgcn_sched_barrier(0);
        AS_STEP(acc, b0, 8, ks); __builtin_amdgcn_sched_barrier(0);
        AS_LOADB(b0, wf, 8, ks + 3); __builtin_amdgcn_sched_barrier(0);
        AS_STEP(acc, b1, 8, ks + 1); __builtin_amdgcn_sched_barrier(0);
        AS_LOADB(b1, wf, 8, (ks + 4 < 32 ? ks + 4 : 31)); __builtin_amdgcn_sched_barrier(0);
        AS_STEP(acc, b2, 8, ks + 2); __builtin_amdgcn_sched_barrier(0);
    }
    AS_STEP(acc, b0, 8, 30); __builtin_amdgcn_sched_barrier(0);
    AS_STEP(acc, b1, 8, 31); __builtin_amdgcn_sched_barrier(0);
    bf16* dst = (w < 4) ? dlo : dhi;
    const int colw = 128 * (w & 3) + 8 * fq;
#pragma unroll
    for (int mt = 0; mt < 4; ++mt) { const size_t row = row0 + 16 * mt + fr;
#pragma unroll
        for (int p = 0; p < 4; ++p) { f32x4 v0 = acc[mt][2 * p] * rs[mt], v1 = acc[mt][2 * p + 1] * rs[mt];
            if (w >= 4) { v0 = silu4(v0); v1 = silu4(v1); } else if (PASS) { v0 = v0 * QSCALE; v1 = v1 * QSCALE; }
            *(v4u*)(dst + row * 512 + colw + 32 * p) = pack8(v0, v1);
            if (PASS == 0 && w < 4) { const int j = (int)(row & (SEQ - 1)) - (SEQ - 3);
                if (j >= 0) { float* o = out + O_CP + (size_t)((row >> 13) * 3 + j) * 512 + colw + 32 * p; *(f32x4*)o = v0; *(f32x4*)(o + 4) = v1; } } } }
}
__device__ __forceinline__ void proj_unit(LAS unsigned char* lds, int u, const ProjArgs& P) {
    int tid = threadIdx.x; asm volatile("" : "+v"(tid));
    const int lane = tid & 63, w = __builtin_amdgcn_readfirstlane(tid >> 6), fr = lane & 15, fq = lane >> 4;
    const size_t row0 = (size_t)u * 64;
    LAS float* rsl = (LAS float*)(lds + A_RS);
    {
        v4u pfa[8]; l2_warm_issue<8>(pfa, P.WA, tid);
        f32x4 v[8][4];
#pragma unroll
        for (int r = 0; r < 8; ++r)
#pragma unroll
            for (int j = 0; j < 4; ++j) v[r][j] = __builtin_nontemporal_load((const f32x4*)(P.x + (row0 + 8 * w + r) * DM) + lane + 64 * j);
        __builtin_amdgcn_sched_barrier(0);
#pragma unroll
        for (int r = 0; r < 8; ++r) { const int row = 8 * w + r; float s = 0.f;
#pragma unroll
            for (int j = 0; j < 4; ++j) { s += (v[r][j].x * v[r][j].x + v[r][j].y * v[r][j].y) + (v[r][j].z * v[r][j].z + v[r][j].w * v[r][j].w);
                v2u o; o.x = pg8::cvt_pk_bf16(v[r][j].x, v[r][j].y); o.y = pg8::cvt_pk_bf16(v[r][j].z, v[r][j].w);
                *(LAS v2u*)(lds + (j < 2 ? A_LO : A_HI) + row * A_STRIDE + ((4 * lane + 256 * j) & 511) * 2) = o;
                *(v2u*)(P.XB2 + (row0 + row) * DM + 4 * lane + 256 * j) = o; }
            s = wave_sum(s);
            if (lane == 0) rsl[row] = rsqrtf(s * (1.0f / DM) + EPS); }
        v4u pfb[8], pfc[2]; l2_warm_issue<8>(pfb, P.WB, tid); l2_warm_issue<2>(pfc, P.WKV, tid);
        __builtin_amdgcn_sched_barrier(0);
        l2_warm_retire<8>(pfa, P.sink); l2_warm_retire<8>(pfb, P.sink); l2_warm_retire<2>(pfc, P.sink);
    }
    LDS_WAIT(); __syncthreads();
    const LAS unsigned char* abase = lds + fr * A_STRIDE + fq * 16;
    float rs[4];
#pragma unroll
    for (int mt = 0; mt < 4; ++mt) rs[mt] = rsl[16 * mt + fr];
    proj_pass<0>(abase, row0, w, lane, fr, fq, rs, P.WA, P.XR, P.SGR, P.out);
    proj_pass<1>(abase, row0, w, lane, fr, fq, rs, P.WB, P.Q, P.SGA, P.out);
    {
        const bf16* wf = P.WKV + (size_t)w * (32 * 2 * 64 * 8) + lane * 8;
        f32x4 acc[4][2];
#pragma unroll
        for (int mt = 0; mt < 4; ++mt)
#pragma unroll
            for (int nt = 0; nt < 2; ++nt) acc[mt][nt] = (f32x4){0.f, 0.f, 0.f, 0.f};
        bf16x8 bA[8][2], bB[8][2];
#define KV_LOADB(dst, k0) do { _Pragma("unroll") for (int k = 0; k < 8; ++k) AS_LOADB(dst[k], wf, 2, (k0) + k); } while (0)
#define KV_COMPUTE(bw, k0) do { _Pragma("unroll") for (int k = 0; k < 8; ++k) AS_STEP(acc, bw[k], 2, (k0) + k); } while (0)
        KV_LOADB(bA, 0); KV_LOADB(bB, 8); __builtin_amdgcn_sched_barrier(0);
        KV_COMPUTE(bA, 0);  __builtin_amdgcn_sched_barrier(0); KV_LOADB(bA, 16); __builtin_amdgcn_sched_barrier(0);
        KV_COMPUTE(bB, 8);  __builtin_amdgcn_sched_barrier(0); KV_LOADB(bB, 24); __builtin_amdgcn_sched_barrier(0);
        KV_COMPUTE(bA, 16); __builtin_amdgcn_sched_barrier(0);
        KV_COMPUTE(bB, 24); __builtin_amdgcn_sched_barrier(0);
#undef KV_LOADB
#undef KV_COMPUTE
        const int col = 32 * w + 8 * fq;
#pragma unroll
        for (int mt = 0; mt < 4; ++mt) { const size_t row = row0 + 16 * mt + fr; const int wi = (int)(row & (SEQ - 1)) - (SEQ - WIN);
            const f32x4 v0 = acc[mt][0] * rs[mt], v1 = acc[mt][1] * rs[mt];
            *(v4u*)(P.KV + row * 256 + col) = pack8(v0, v1);
            if (wi >= 0) { float* o = P.out + (col < 128 ? O_KP : O_VP) + (size_t)((row >> 13) * WIN + wi) * 128 + (col & 127); *(f32x4*)o = v0; *(f32x4*)(o + 4) = v1; } }
    }
    __syncthreads();
}
struct SprojArgs { const bf16* XB; const bf16 *WA, *WB, *WKV; const float* RSTD; bf16 *XR, *SGR, *Q, *KV, *SGA; float* out; };
__device__ __forceinline__ void sample_proj_unit(LAS unsigned char* lds, int sl, const SprojArgs& P) {
    int tid = threadIdx.x; asm volatile("" : "+v"(tid));
    const int lane = tid & 63, w = __builtin_amdgcn_readfirstlane(tid >> 6), fr = lane & 15, fq = lane >> 4;
    const int rg = sl / 36, cg = sl % 36, pass = cg >> 4;
    const bf16* wa_ = P.WA; const bf16* wb_ = P.WB; const bf16* wkv_ = P.WKV;
    const bf16* ap = P.XB + (size_t)(MP + 32 * rg + fr) * DM + 128 * w + 8 * fq;
    bf16x8 af[2][4], bw[4][4];
#pragma unroll
    for (int j = 0; j < 4; ++j) {
        const int slab = pass < 2 ? (cg >> 1) & 7 : 2 * (cg - 32) + (j >> 1), nta = pass < 2 ? 4 * (cg & 1) + j : (j & 1), NTT = pass < 2 ? 8 : 2;
        const bf16* bp = (pass == 0 ? wa_ : pass == 1 ? wb_ : wkv_) + ((size_t)(slab * 32 * NTT + nta) * 64 + lane) * 8;
#pragma unroll
        for (int k = 0; k < 4; ++k) bw[j][k] = *(const bf16x8*)(bp + (size_t)(4 * w + k) * NTT * 512); }
#pragma unroll
    for (int mt = 0; mt < 2; ++mt)
#pragma unroll
        for (int k = 0; k < 4; ++k) af[mt][k] = *(const bf16x8*)(ap + (size_t)(16 * mt) * DM + 32 * k);
    const int tmt = w >> 2, tj = w & 3;
    const float rstd_row = P.RSTD[(size_t)MP + 32 * rg + 16 * tmt + fr];
    __builtin_amdgcn_sched_barrier(0);
    LAS float* red = (LAS float*)lds;
#pragma unroll
    for (int mt = 0; mt < 2; ++mt)
#pragma unroll
        for (int j = 0; j < 4; ++j) { f32x4 acc = {0.f, 0.f, 0.f, 0.f};
#pragma unroll
            for (int k = 0; k < 4; ++k) acc = __builtin_amdgcn_mfma_f32_16x16x32_bf16(bw[j][k], af[mt][k], acc, 0, 0, 0);
            *(LAS f32x4*)(red + ((w * 8 + mt * 4 + j) * 64 + lane) * 4) = acc; }
    LDS_WAIT(); __syncthreads();
    f32x4 v = {0.f, 0.f, 0.f, 0.f};
#pragma unroll
    for (int ww = 0; ww < 8; ++ww) v += *(const LAS f32x4*)(red + ((ww * 8 + w) * 64 + lane) * 4);
    const int b = 32 * rg + 16 * tmt + fr; const size_t row = (size_t)MP + b;
    v = v * rstd_row;
    const int slab = pass < 2 ? (cg >> 1) & 7 : 2 * (cg - 32) + (tj >> 1), nt = pass < 2 ? 4 * (cg & 1) + tj : (tj & 1);
    const int cin = 32 * (nt >> 1) + 8 * fq + 4 * (nt & 1);
    v2u o;
    if (pass < 2) { const int col = 128 * (slab & 3) + cin;
        if (slab >= 4) v = silu4(v); else if (pass) v = v * QSCALE;
        o.x = pg8::cvt_pk_bf16(v.x, v.y); o.y = pg8::cvt_pk_bf16(v.z, v.w);
        bf16* q_ = P.Q; bf16* sga_ = P.SGA; bf16* xr_ = P.XR; bf16* sgr_ = P.SGR;
        bf16* dst = pass ? (slab < 4 ? q_ : sga_) : (slab < 4 ? xr_ : sgr_);
        *(v2u*)(dst + row * 512 + col) = o;
        if (pass == 0 && slab < 4) *(f32x4*)(P.out + O_CS + (size_t)(b * 3 + 2) * 512 + col) = v; }
    else { const int col = 32 * slab + cin;
        o.x = pg8::cvt_pk_bf16(v.x, v.y); o.y = pg8::cvt_pk_bf16(v.z, v.w);
        *(v2u*)(P.KV + row * 256 + col) = o;
        *(f32x4*)(P.out + (col < 128 ? O_KS : O_VS) + (size_t)b * 16384 + 127 * 128 + (col & 127)) = v; }
    __syncthreads();
}

__device__ __forceinline__ void out_unit(LAS unsigned char* lds, int b, int c, const unsigned* UV, const bf16* ATT, const float* AGG, const bf16* WF, const bf16* x, const float* gpost, float* y, float* out, bool att_in_lds) {
    int tid = threadIdx.x; asm volatile("" : "+v"(tid));
    const int lane = tid & 63, w = __builtin_amdgcn_readfirstlane(tid >> 6), fr = lane & 15, fq = lane >> 4;
    const size_t row0 = (size_t)b * SEQ + 64 * c;
    v4u pfo[8]; l2_warm_issue<8>(pfo, WF, tid);
    {
        const float* ag = AGG + (size_t)b * NCHUNK * 1024 + tid;
        const int q = c >> 3;
        float pa[8], pb[8];
#pragma unroll
        for (int k = 0; k < 8; ++k) { pa[k] = 1.f; pb[k] = 0.f; }
        float ta[7], tb[7];
#pragma unroll
        for (int jj = 0; jj < 7; ++jj) { const int j = (8 * q + jj < c) ? 8 * q + jj : (c > 0 ? c - 1 : 0); ta[jj] = ag[(size_t)j * 1024]; tb[jj] = ag[(size_t)j * 1024 + 512]; }
        const float ca = ag[(size_t)c * 1024], cb = ag[(size_t)c * 1024 + 512];
        __builtin_amdgcn_sched_barrier(0);
#pragma unroll 1
        for (int j0 = 0; j0 < q; j0 += 8) {
            float A[8][8], B[8][8];
#pragma unroll
            for (int k = 0; k < 8; ++k)
#pragma unroll
                for (int jj = 0; jj < 8; ++jj) { const int j = (j0 + jj < q) ? j0 + jj : q - 1; A[k][jj] = ag[(size_t)(k * q + j) * 1024]; B[k][jj] = ag[(size_t)(k * q + j) * 1024 + 512]; }
            __builtin_amdgcn_sched_barrier(0);
#pragma unroll
            for (int jj = 0; jj < 8; ++jj) if (j0 + jj < q) {
#pragma unroll
                for (int k = 0; k < 8; ++k) { pb[k] = A[k][jj] * pb[k] + B[k][jj]; pa[k] *= A[k][jj]; } }
            __builtin_amdgcn_sched_barrier(0);
        }
        float hin = pb[0];
#pragma unroll
        for (int k = 1; k < 8; ++k) hin = pa[k] * hin + pb[k];
#pragma unroll
        for (int jj = 0; jj < 7; ++jj) if (8 * q + jj < c) hin = ta[jj] * hin + tb[jj];
        ((LAS float*)(lds + A_HIN))[tid] = hin;
        l2_warm_retire<8>(pfo, (unsigned*)(out + O_RP));
        if (c == NCHUNK - 1) out[O_RP + b * 512 + tid] = ca * hin + cb;
    }
    VM_WAIT(); __syncthreads();
    {   typedef f16 f16x8 __attribute__((ext_vector_type(8)));
        f16x8 p0[8], p1[8]; v4u at[8];
#pragma unroll
        for (int i = 0; i < 8; ++i) { const int e = tid + 512 * i, r = e >> 6, cc = e & 63;
            p0[i] = *(const f16x8*)(UV + (row0 + r) * 512 + cc * 8); p1[i] = *(const f16x8*)(UV + (row0 + r) * 512 + cc * 8 + 4);
            at[i] = *(const v4u*)(ATT + (row0 + (att_in_lds ? 0 : r)) * 512 + cc * 8); }
        __builtin_amdgcn_sched_barrier(0);
        LDS_WAIT(); __syncthreads();
#pragma unroll
        for (int i = 0; i < 8; ++i) { const int e = tid + 512 * i, r = e >> 6, cc = e & 63;
            const f32x4 h0 = *(const LAS f32x4*)(lds + A_HIN + cc * 32), h1 = *(const LAS f32x4*)(lds + A_HIN + cc * 32 + 16);
            v4u o; o.x = pg8::cvt_pk_bf16((float)p0[i][0] + (float)p0[i][1] * h0.x, (float)p0[i][2] + (float)p0[i][3] * h0.y); o.y = pg8::cvt_pk_bf16((float)p0[i][4] + (float)p0[i][5] * h0.z, (float)p0[i][6] + (float)p0[i][7] * h0.w);
            o.z = pg8::cvt_pk_bf16((float)p1[i][0] + (float)p1[i][1] * h1.x, (float)p1[i][2] + (float)p1[i][3] * h1.y); o.w = pg8::cvt_pk_bf16((float)p1[i][4] + (float)p1[i][5] * h1.z, (float)p1[i][6] + (float)p1[i][7] * h1.w);
            *(LAS v4u*)(lds + A_RNN + r * A_STRIDE + cc * 16) = o; if (!att_in_lds) *(LAS v4u*)(lds + A_ATT + r * A_STRIDE + cc * 16) = at[i]; }
    }
    LDS_WAIT(); __syncthreads();
    f32x4 acc[4][8];
#pragma unroll
    for (int mt = 0; mt < 4; ++mt)
#pragma unroll
        for (int nt = 0; nt < 8; ++nt) acc[mt][nt] = (f32x4){0.f, 0.f, 0.f, 0.f};
    const bf16* wf = WF + (size_t)w * (32 * 8 * 64 * 8) + lane * 8;
    const LAS unsigned char* abase = lds + fr * A_STRIDE + fq * 16;
    bf16x8 b0[8], b1[8];
#define OU_LOADB(dst, ks) do { _Pragma("unroll") for (int nt = 0; nt < 8; ++nt) dst[nt] = *(const bf16x8*)(wf + (size_t)(((ks) * 8 + nt) * 512)); } while (0)
#define OU_STEP(bw, ks) do { bf16x8 af[4]; const LAS unsigned char* ap = abase + (((ks) < 16) ? A_RNN : A_ATT) + (((ks) & 15) * 64); \
        _Pragma("unroll") for (int mt = 0; mt < 4; ++mt) af[mt] = *(const LAS bf16x8*)(ap + mt * 16 * A_STRIDE); \
        _Pragma("unroll") for (int mt = 0; mt < 4; ++mt) _Pragma("unroll") for (int nt = 0; nt < 8; ++nt) acc[mt][nt] = __builtin_amdgcn_mfma_f32_16x16x32_bf16(bw[nt], af[mt], acc[mt][nt], 0, 0, 0); } while (0)
    OU_LOADB(b0, 0);
#pragma unroll 1
    for (int ks = 0; ks < 32; ks += 2) {
        OU_LOADB(b1, ks + 1); __builtin_amdgcn_sched_barrier(0);
        OU_STEP(b0, ks); __builtin_amdgcn_sched_barrier(0);
        OU_LOADB(b0, (ks + 2 < 32 ? ks + 2 : 31)); __builtin_amdgcn_sched_barrier(0);
        OU_STEP(b1, ks + 1); __builtin_amdgcn_sched_barrier(0);
    }
#undef OU_LOADB
#undef OU_STEP
    int tid2 = threadIdx.x; asm volatile("" : "+v"(tid2)); const int fr2 = tid2 & 15, fq2 = (tid2 >> 4) & 3;
    LAS float* part = (LAS float*)(lds + A_PART);
#pragma unroll
    for (int mt = 0; mt < 4; ++mt) { float ss = 0.f;
#pragma unroll
        for (int nt = 0; nt < 8; ++nt) { const f32x4 v = acc[mt][nt]; ss += (v.x * v.x + v.y * v.y) + (v.z * v.z + v.w * v.w); }
        ss += __shfl_xor(ss, 16); ss += __shfl_xor(ss, 32);
        if (fq2 == 0) part[w * 64 + 16 * mt + fr2] = ss; }
    LDS_WAIT(); __syncthreads();
    constexpr int YS = 4112;
    const int lane2 = tid2 & 63;
    f32x4 gv[4];
#pragma unroll
    for (int j = 0; j < 4; ++j) gv[j] = *(const f32x4*)(gpost + 4 * lane2 + 256 * j);
    v2u xv[2][2][4];
    const bf16* xb0 = x + (row0 + 2 * w) * DM + 4 * lane2;
#pragma unroll
    for (int rr = 0; rr < 2; ++rr)
#pragma unroll
        for (int j = 0; j < 4; ++j) xv[0][rr][j] = __builtin_nontemporal_load((const v2u*)(xb0 + (size_t)rr * DM + 256 * j));
    __builtin_amdgcn_sched_barrier(0);
#pragma unroll
    for (int mt = 0; mt < 4; ++mt) { float ss = 0.f;
        if (mt < 3) {
#pragma unroll
            for (int rr = 0; rr < 2; ++rr)
#pragma unroll
                for (int j = 0; j < 4; ++j) xv[(mt + 1) & 1][rr][j] = __builtin_nontemporal_load((const v2u*)(xb0 + (size_t)(16 * (mt + 1) + rr) * DM + 256 * j));
        }
        __builtin_amdgcn_sched_barrier(0);
#pragma unroll
        for (int ww = 0; ww < 8; ++ww) ss += part[ww * 64 + 16 * mt + fr2];
        const float rs = rsqrtf(ss * (1.0f / DM) + EPS);
#pragma unroll
        for (int nt = 0; nt < 8; ++nt) *(LAS f32x4*)(lds + fr2 * YS + (128 * w + 16 * nt + 4 * fq2) * 4) = acc[mt][nt] * rs;
        LDS_WAIT(); __syncthreads();
#pragma unroll
        for (int rr = 0; rr < 2; ++rr)
#pragma unroll
            for (int j = 0; j < 4; ++j) { const f32x4 v = *(const LAS f32x4*)(lds + (2 * w + rr) * YS + (4 * lane2 + 256 * j) * 4);
                const v2u xq = xv[mt & 1][rr][j]; const f32x4 xf = {__uint_as_float(xq.x << 16), __uint_as_float(xq.x & 0xffff0000u), __uint_as_float(xq.y << 16), __uint_as_float(xq.y & 0xffff0000u)};
                __builtin_nontemporal_store(xf + v * gv[j], (f32x4*)(y + (row0 + 16 * mt + 2 * w + rr) * DM + 4 * lane2 + 256 * j)); }
        LDS_WAIT(); __syncthreads(); }
}
typedef unsigned long long u64x2 __attribute__((ext_vector_type(2)));
__device__ __forceinline__ u64x2 ld16_sc1(const void* p) { const unsigned long long* q = (const unsigned long long*)p;
    u64x2 r; r.x = __hip_atomic_load(q, __ATOMIC_RELAXED, __HIP_MEMORY_SCOPE_AGENT); r.y = __hip_atomic_load(q + 1, __ATOMIC_RELAXED, __HIP_MEMORY_SCOPE_AGENT); return r; }
__device__ __forceinline__ void sample_out_unit(LAS unsigned char* lds, int su, const bf16* MIX, const bf16* WF, float* OUTS) {
    int tid = threadIdx.x; asm volatile("" : "+v"(tid));
    const int lane = tid & 63, w = __builtin_amdgcn_readfirstlane(tid >> 6), fr = lane & 15, fq = lane >> 4;
    const int rg = su >> 4, cg = su & 15;
    const bf16* bp = WF + ((size_t)((cg >> 1) * 32 * 8 + 4 * (cg & 1)) * 64 + lane) * 8;
    const bf16* ap = MIX + (size_t)(MP + 32 * rg + fr) * DM + 128 * w + 8 * fq;
    bf16x8 af[2][4], bw[4][4];
#pragma unroll
    for (int k = 0; k < 4; ++k) {
#pragma unroll
        for (int j = 0; j < 4; ++j) bw[j][k] = *(const bf16x8*)(bp + (size_t)(4 * w + k) * 8 * 512 + j * 512);
#pragma unroll
        for (int mt = 0; mt < 2; ++mt) af[mt][k] = *(const bf16x8*)(ap + (size_t)(16 * mt) * DM + 32 * k); }
    __builtin_amdgcn_sched_barrier(0);
    LAS float* red = (LAS float*)lds;
#pragma unroll
    for (int mt = 0; mt < 2; ++mt)
#pragma unroll
        for (int j = 0; j < 4; ++j) { f32x4 acc = {0.f, 0.f, 0.f, 0.f};
#pragma unroll
            for (int k = 0; k < 4; ++k) acc = __builtin_amdgcn_mfma_f32_16x16x32_bf16(bw[j][k], af[mt][k], acc, 0, 0, 0);
            *(LAS f32x4*)(red + ((w * 8 + mt * 4 + j) * 64 + lane) * 4) = acc; }
    LDS_WAIT(); __syncthreads();
    f32x4 v = {0.f, 0.f, 0.f, 0.f};
#pragma unroll
    for (int ww = 0; ww < 8; ++ww) v += *(const LAS f32x4*)(red + ((ww * 8 + w) * 64 + lane) * 4);
    { float* op = OUTS + (size_t)(32 * rg + 16 * (w >> 2) + fr) * DM + 128 * (cg >> 1) + 16 * (4 * (cg & 1) + (w & 3)) + 4 * fq;
      asm volatile("global_store_dwordx4 %0, %1, off sc0 sc1\n\ts_nop 1" :: "v"(op), "v"(v) : "memory"); }
    __syncthreads();
}

#ifndef MK_N_LAUNCHES
#define MK_N_LAUNCHES 1
#endif
constexpr int N_PHASES = 3;
struct Args { const float* in[19]; float* out; unsigned char* ws; int ph_lo, ph_hi; };
static_assert(sizeof(Args) == 19 * 8 + 8 + 8 + 8, "Args has no padding");

__global__ void __launch_bounds__(512, 2) mk_fwd(Args args) {
    extern __shared__ __attribute__((aligned(16))) unsigned char lds_raw[];
    LAS unsigned char* lds = (LAS unsigned char*)lds_raw;
    volatile LAS unsigned* MISC = (volatile LAS unsigned*)(lds + MISC_OFF);
    const int tid = threadIdx.x, lane = tid & 63, wave = __builtin_amdgcn_readfirstlane(tid >> 6);
    const int G = gridDim.x, bid = blockIdx.x;
    unsigned char* ws = args.ws; float* out = args.out;
    const float* x_prompt = args.in[0]; const float* x_sample = args.in[1]; const float* state_conv = args.in[2]; const float* state_rnn = args.in[3];
    const float* cache_k = args.in[4]; const float* cache_v = args.in[5]; const float* norm_pre = args.in[6]; const float* norm_post = args.in[7];
    const float* w_in = args.in[8]; const float* conv_w = args.in[9]; const float* conv_b = args.in[10]; const float* w_a = args.in[11]; const float* b_a = args.in[12];
    const float* w_x = args.in[13]; const float* b_x = args.in[14]; const float* lam = args.in[15]; const float* sinks = args.in[16]; const float* rel_bias = args.in[17];
    const float* w_out = args.in[18];
    bf16* WA = (bf16*)(ws + WS_WA); bf16* WB = (bf16*)(ws + WS_WB); bf16* WT_OUT = (bf16*)(ws + WS_WOUT); bf16* WG = (bf16*)(ws + WS_WG); bf16* WKV = (bf16*)(ws + WS_WKV); float* RSTD = (float*)(ws + WS_RSTD); float* AGG = (float*)(ws + WS_AGG);
    bf16* XB = (bf16*)(ws + WS_XB); bf16* XR = (bf16*)(ws + WS_XR); bf16* SGR = (bf16*)(ws + WS_SGR); bf16* Qb = (bf16*)(ws + WS_Q); bf16* SGA = (bf16*)(ws + WS_SGA);
    bf16* KV = (bf16*)(ws + WS_KV); bf16* MIX = (bf16*)(ws + WS_MIX); float* OUTS = (float*)(ws + WS_OUTS);
    unsigned* ctl = (unsigned*)(ws + WS_CTL);

    if (wave >= 4) __builtin_amdgcn_s_setprio(1);
    for (int u = tid; u < (LDS_BYTES - LDSCTL_OFF) / 4; u += 512) ((LAS unsigned*)(lds + LDSCTL_OFF))[u] = 0u;
    __syncthreads();
    XcdBarrier bar; bar.bar = ctl + CW_BAR; bar.x = 0; bar.st = nullptr;
    if (MK_N_LAUNCHES == 1) bar = xcd_barrier_post(ctl + CW_BAR, MISC + 8);
    const int lo = args.ph_lo, hi = args.ph_hi;
    SmpPre spre;
#pragma unroll
    for (int i = 0; i < 4; ++i) { spre.kk[i] = (f32x4){0.f, 0.f, 0.f, 0.f}; spre.vv[i] = (f32x4){0.f, 0.f, 0.f, 0.f}; }
#define IN(k) (lo <= (k) && (k) < hi)
#define BOTH(k) (IN(k) && IN((k) + 1))
#define GRID_BAR() do { if (MK_N_LAUNCHES == 1) xcd_barrier(bar); } while (0)

    if (IN(0)) {
        LAS float* scr = (LAS float*)(lds + wave * 16384);
        const int gw = wave * G + bid, NGW = G * 8;
        constexpr int I_IN = (DM / 64) * (DIN / 32), I_OUT = (DM / 64) * (DM / 32), I_G = 16 * 2;
        for (int it = gw; it < I_IN + I_OUT + I_G; it += NGW) {
            int r = it;
            if (r < I_IN) { const int n0 = 32 * (r % (DIN / 32));
                if (n0 < 1024) p0_transpose_item<3>(w_in, DM, DIN, WA, norm_pre, scr, r, lane, n0);
                else if (n0 < 1536) p0_transpose_item<3>(w_in, DM, DIN, WB, norm_pre, scr, r, lane, n0 - 1024);
                else if (n0 < 1792) p0_transpose_item<4>(w_in, DM, DIN, WKV, norm_pre, scr, r, lane, n0 - 1536);
                else p0_transpose_item<3>(w_in, DM, DIN, WB, norm_pre, scr, r, lane, n0 - 1792 + 512);
                continue; } r -= I_IN;
            if (r < I_OUT) { p0_transpose_item<1>(w_out, DM, DM, WT_OUT, nullptr, scr, r, lane, 32 * (r % (DM / 32))); continue; } r -= I_OUT;
            { const int mat = r >> 1, blk = mat >> 1, gate = mat & 1; p0_transpose_item<0>((gate ? w_x : w_a) + blk * 4096, 64, 64, WG + (size_t)mat * 4096, nullptr, scr, r & 1, lane, 32 * (r & 1), -LOG2E); }
        }
        for (int m0 = MP + (NGW - 1 - gw) * 8; m0 < MT; m0 += NGW * 8) {
            const float* xr[8]; bf16* orow[8]; float* rsp[8];
#pragma unroll
            for (int r = 0; r < 8; ++r) { const int m = m0 + r; xr[r] = x_sample + (size_t)(m - MP) * DM; orow[r] = XB + (size_t)m * DM; rsp[r] = RSTD + m; }
            p0_rows<8>(xr, orow, rsp, lane);
        }
        if (BOTH(0)) GRID_BAR();
    }
    if (IN(1)) {
        {
            ProjArgs PA{x_prompt, WA, WB, WKV, XR, SGR, Qb, SGA, KV, out, ctl + 960, (bf16*)(ws + WS_XB2)};
            SprojArgs SP{XB, WA, WB, WKV, RSTD, XR, SGR, Qb, KV, SGA, out};
            const int nsl = DIN / 16;
            const int sl_first = ((bid & 1) && (bid >> 1) < 128) ? (bid >> 1) : -1, sl_last = (!(bid & 1) && (bid >> 1) < nsl - 128 && G >= 256) ? 128 + (bid >> 1) : -1;
            if (G >= 256) { if (sl_first >= 0) sample_proj_unit(lds, sl_first, SP); }
            else for (int sl = bid; sl < nsl; sl += G) sample_proj_unit(lds, sl, SP);
            for (int u = bid; u < MP / 64; u += G) proj_unit(lds, u, PA);
            if (sl_last >= 0) sample_proj_unit(lds, sl_last, SP);
        }
        if (BOTH(1)) {
            LAS float* btab0 = (LAS float*)(lds + BTAB_OFF);
            for (int e = tid; e < 1024; e += 512) { const int h = e >> 7, d = e & 127; btab0[e] = rel_bias[t5_bucket(d) * NH + h] * LOG2E; }
            attn_table(lds, rel_bias);
            if (bid < 2 * DECB && !(G >= 256 && ((bid >> 1) & 1))) sample_prefetch(spre, cache_k, cache_v, bid >> 1, bid & 1, tid);
            GRID_BAR();
        }
    }
    if (IN(2)) {
        LAS float* btab = (LAS float*)(lds + BTAB_OFF);
        const bool pre_ok = BOTH(1);
        if (!pre_ok) { for (int e = tid; e < 1024; e += 512) { const int h = e >> 7, d = e & 127; btab[e] = rel_bias[t5_bucket(d) * NH + h] * LOG2E; } }
        __syncthreads();
        RgArgs R{XR, SGR, WG, conv_w, conv_b, b_a, b_x, lam, AGG, (unsigned*)XB};
        SmpArgs SA{XR, SGR, Qb, KV, SGA, WG, state_conv, state_rnn, cache_k, cache_v, conv_w, conv_b, b_a, b_x, lam, sinks, MIX, out};
        const bool r_first = G >= 256 && ((bid >> 1) & 1);
        if (!r_first) {
            if (pre_ok && bid < 2 * DECB) { sample_unit<true>(lds, btab, SA, bid >> 1, bid & 1, ctl + CW_SMP, spre);
                for (int u = bid + G; u < 2 * DECB; u += G) sample_unit<false>(lds, btab, SA, u >> 1, u & 1, ctl + CW_SMP, spre); }
            else for (int u = bid; u < 2 * DECB; u += G) sample_unit<false>(lds, btab, SA, u >> 1, u & 1, ctl + CW_SMP, spre);
        }
        for (int u = bid; u < BATCH * NCHUNK; u += G) { rglru_unit(lds, R, u / NCHUNK, u % NCHUNK);
            if (tid == 0) __hip_atomic_fetch_add(ctl + CW_AGG, 1u, __ATOMIC_RELAXED, __HIP_MEMORY_SCOPE_AGENT); }
        if (r_first) for (int u = bid; u < 2 * DECB; u += G) sample_unit<false>(lds, btab, SA, u >> 1, u & 1, ctl + CW_SMP, spre);
        {
            bool waited = false;
            const int sob = G >= 192 ? 128 : 0;
            for (int su = bid - sob; su >= 0 && su < 64; su += G) {
                if (!waited) {
                    if (tid == 0) { unsigned sp = 0; while (__hip_atomic_load(ctl + CW_SMP, __ATOMIC_RELAXED, __HIP_MEMORY_SCOPE_AGENT) < (unsigned)(2 * DECB)) { __builtin_amdgcn_s_sleep(2); if (++sp > (1u << 22)) break; }
                        __builtin_amdgcn_fence(__ATOMIC_ACQUIRE, "agent"); VM_WAIT(); }
                    __syncthreads(); waited = true; }
                sample_out_unit(lds, su, MIX, WT_OUT, OUTS);
                VM_WAIT(); __syncthreads();
                if (tid == 0) __hip_atomic_fetch_add(ctl + CW_OUTS, 1u, __ATOMIC_RELAXED, __HIP_MEMORY_SCOPE_AGENT);
            }
        }
        for (int u = bid; u < BATCH * NCHUNK; u += G) attn_unit(lds, u / NCHUNK, u % NCHUNK, Qb, KV, SGA, sinks, rel_bias, Qb, !(pre_ok && u == bid), BATCH * NCHUNK <= G);
        {
            if (tid == 0) { unsigned sp = 0; while (__hip_atomic_load(ctl + CW_AGG, __ATOMIC_RELAXED, __HIP_MEMORY_SCOPE_AGENT) < (unsigned)(BATCH * NCHUNK)) { __builtin_amdgcn_s_sleep(2); if (++sp > (1u << 22)) break; }
                __builtin_amdgcn_fence(__ATOMIC_ACQUIRE, "agent"); VM_WAIT(); }
            __syncthreads();
        }
        for (int u = bid; u < BATCH * NCHUNK; u += G) out_unit(lds, u / NCHUNK, u % NCHUNK, (const unsigned*)XB, Qb, AGG, WT_OUT, (const bf16*)(ws + WS_XB2), norm_post, out + O_YP, out, BATCH * NCHUNK <= G);
        if (bid < DECB) {
            if (tid == 0) { unsigned sp = 0; while (__hip_atomic_load(ctl + CW_OUTS, __ATOMIC_RELAXED, __HIP_MEMORY_SCOPE_AGENT) < 64u) { __builtin_amdgcn_s_sleep(2); if (++sp > (1u << 22)) break; } }
            __syncthreads();
            for (int b = bid; b < DECB; b += G) if (wave == 0) {
                const f32x4* r4 = (const f32x4*)(OUTS + (size_t)b * DM) + lane; const f32x4* x4 = (const f32x4*)(x_sample + (size_t)b * DM) + lane; f32x4* y4 = (f32x4*)(out + O_YS + (size_t)b * DM) + lane;
                f32x4 v[4]; float ss = 0.f;
#pragma unroll
                for (int j = 0; j < 4; ++j) { v[j] = __builtin_bit_cast(f32x4, ld16_sc1(r4 + 64 * j)); ss += (v[j].x * v[j].x + v[j].y * v[j].y) + (v[j].z * v[j].z + v[j].w * v[j].w); }
                const float rs = rsqrtf(wave_sum(ss) * (1.0f / DM) + EPS);
#pragma unroll
                for (int j = 0; j < 4; ++j) { const f32x4 gg = ((const f32x4*)norm_post)[lane + 64 * j]; y4[64 * j] = x4[64 * j] + v[j] * rs * gg; }
            }
        }
    }
#undef IN
#undef BOTH
#undef GRID_BAR
}

extern "C" void kernel_launch(void* const* d_in, const int* in_sizes, int n_in, void* d_out, int out_size, void* d_ws, size_t ws_size, hipStream_t stream) {
    static int grid = 0;
    if (grid == 0) {
        int dev = 0, cus = 0;
        if (hipGetDevice(&dev) != hipSuccess || hipDeviceGetAttribute(&cus, hipDeviceAttributeMultiprocessorCount, dev) != hipSuccess) { fprintf(stderr, "kernel_launch: device query failed\n"); grid = -1; return; }
        if (hipFuncSetAttribute((const void*)mk_fwd, hipFuncAttributeMaxDynamicSharedMemorySize, LDS_BYTES) != hipSuccess) { fprintf(stderr, "kernel_launch: hipFuncSetAttribute failed\n"); grid = -1; return; }
        int per_cu = 0;
        if (hipOccupancyMaxActiveBlocksPerMultiprocessor(&per_cu, (const void*)mk_fwd, 512, LDS_BYTES) != hipSuccess || per_cu < 1) { fprintf(stderr, "kernel_launch: occupancy query says %d blocks/CU\n", per_cu); }
        (void)hipGetLastError();
        grid = cus;
    }
    if (grid < 0) return;
    (void)hipMemsetAsync((char*)d_ws + WS_CTL, 0, CTL_ZERO_BYTES, stream);
    Args a{};
    for (int i = 0; i < 19; ++i) a.in[i] = (const float*)d_in[i];
    a.out = (float*)d_out; a.ws = (unsigned char*)d_ws;
    if (MK_N_LAUNCHES == 1) { a.ph_lo = 0; a.ph_hi = N_PHASES; hipLaunchKernelGGL(mk_fwd, dim3(grid), dim3(512), LDS_BYTES, stream, a); }
    else for (int p = 0; p < N_PHASES; ++p) { a.ph_lo = p; a.ph_hi = p + 1; hipLaunchKernelGGL(mk_fwd, dim3(grid), dim3(512), LDS_BYTES, stream, a); }
}
```

```cpp
#include <hip/hip_runtime.h>
#include <cstdint>
#include <cstdio>

namespace pg8 {
__device__ __forceinline__ unsigned cvt_pk_bf16(float lo, float hi) { unsigned r; asm volatile("v_cvt_pk_bf16_f32 %0, %1, %2" : "=v"(r) : "v"(lo), "v"(hi)); return r; }
}

typedef unsigned short bf16;
#define LAS __attribute__((address_space(3)))
#define GAS __attribute__((address_space(1)))
typedef unsigned v4u __attribute__((ext_vector_type(4)));
typedef unsigned v2u __attribute__((ext_vector_type(2)));
typedef float f32x4 __attribute__((ext_vector_type(4)));
typedef short bf16x8 __attribute__((ext_vector_type(8)));
constexpr int DM = 1024, BATCH = 2, SEQ = 8192, DECB = 128;
constexpr int DRNN = 512, DATT = 512, NH = 8, HD = 64, NKV = 2, KVD = 128, WIN = 128, NBUCK = 32;
constexpr int DIN = 2304;
constexpr int MP = BATCH * SEQ;
constexpr int MT = MP + DECB;
constexpr int MPAD = 16640;
constexpr int NCHUNK = SEQ / 64;
constexpr float EPS = 1e-6f;
constexpr float LOG2E = 1.4426950408889634f;
constexpr float QSCALE = 0.125f * LOG2E;

constexpr size_t O_YP = 0, O_YS = O_YP + (size_t)MP * DM, O_CP = O_YS + (size_t)DECB * DM, O_RP = O_CP + 2 * 3 * 512, O_KP = O_RP + 2 * 512,
                 O_VP = O_KP + 2 * 128 * 128, O_CS = O_VP + 2 * 128 * 128, O_RS = O_CS + (size_t)DECB * 3 * 512, O_KS = O_RS + (size_t)DECB * 512,
                 O_VS = O_KS + (size_t)DECB * 128 * 128, O_END = O_VS + (size_t)DECB * 128 * 128;

constexpr size_t MiB = 1u << 20;
constexpr size_t WS_CTL = 0, CTL_ZERO_BYTES = 32768;
constexpr size_t WS_WA = 1 * MiB;
constexpr size_t WS_WB = 3 * MiB;
constexpr size_t WS_WOUT = 6 * MiB;
constexpr size_t WS_WG = 8 * MiB;
constexpr size_t WS_WKV = 8 * MiB + 128 * 1024;
constexpr size_t WS_RSTD = 8 * MiB + 768 * 1024;
constexpr size_t WS_AGG = 9 * MiB;
constexpr size_t WS_XB = 10 * MiB;
constexpr size_t WS_XR = 43 * MiB;
constexpr size_t WS_SGR = 60 * MiB;
constexpr size_t WS_Q = 77 * MiB;
constexpr size_t WS_SGA = 94 * MiB;
constexpr size_t WS_KV = 111 * MiB;
constexpr size_t WS_MIX = 120 * MiB;
constexpr size_t WS_OUTS = 153 * MiB;
constexpr size_t WS_XB2 = 154 * MiB;
constexpr size_t WS_END = 186 * MiB;
constexpr int CW_SMP = 512;
constexpr int CW_AGG = 576;
constexpr int CW_OUTS = 640;
constexpr int CW_BAR = 1024;

constexpr int RING_BYTES = 131072, LDSCTL_OFF = 153600, MISC_OFF = LDSCTL_OFF + 320, LDS_BYTES = 155648;
constexpr int A_STRIDE = 1040;
constexpr int A_ATT = 0, A_RNN = 66560, A_PART = 133120, A_HIN = 135168;
static_assert(A_RNN + 64 * A_STRIDE <= A_PART && A_HIN + 2048 <= LDSCTL_OFF, "lds map");

#define LDS_WAIT() asm volatile("s_waitcnt lgkmcnt(0)" ::: "memory")
#define ST_WT128(ptr, val) asm volatile("global_store_dwordx4 %0, %1, off sc0 sc1\n\ts_nop 1" :: "v"(ptr), "v"(val) : "memory")
#define VM_WAIT() asm volatile("s_waitcnt vmcnt(0)" ::: "memory")
__device__ __forceinline__ float bf2f(bf16 v) { return __uint_as_float((unsigned)v << 16); }
__device__ __forceinline__ unsigned f2bf(float f) { unsigned u = __float_as_uint(f); return (u + 0x7fffu + ((u >> 16) & 1u)) >> 16; }
__device__ __forceinline__ unsigned pk2(float lo, float hi) { return f2bf(lo) | (f2bf(hi) << 16); }
__device__ __forceinline__ float ex2(float x) { return __builtin_amdgcn_exp2f(x); }
__device__ __forceinline__ float rcpf_(float x) { return __builtin_amdgcn_rcpf(x); }
__device__ __forceinline__ float sigmoid_(float x) { return rcpf_(1.0f + ex2(-LOG2E * x)); }
__device__ __forceinline__ float silu_(float x) { return x * sigmoid_(x); }
__device__ __forceinline__ int t5_bucket(int dist) {
    if (dist < 0) dist = 0;
    if (dist < 16) return dist;
    const float d = (float)dist;
    int large = 16 + (int)(logf(d / 16.0f) / 2.0794415416798357f * 16.0f);
    return large < 31 ? large : 31;
}
__device__ __forceinline__ float softplus_neg(float l) { return (l > 0.f) ? log1pf(__expf(-l)) : (-l + log1pf(__expf(l))); }
__device__ __forceinline__ float wave_sum(float v) {
#pragma unroll
    for (int o = 1; o < 64; o <<= 1) v += __shfl_xor(v, o);
    return v;
}


#define XB_TMO      128
#define XB_XCNT(j)  (256  + 64 * (j))
#define XB_XSUB(j)  (1280 + 64 * (j))
#define XB_XGEN(j)  (2304 + 64 * (j))
#define XB_TOP      3328
#define XB_TOPGEN   3392
#define XCD_BAR_WORDS 3456
#define XB_SPIN_CAP (1u << 18)
__device__ __forceinline__ unsigned xb_ld(unsigned* p)              { return __hip_atomic_load(p, __ATOMIC_RELAXED, __HIP_MEMORY_SCOPE_AGENT); }
__device__ __forceinline__ unsigned xb_add(unsigned* p, unsigned v) { return __hip_atomic_fetch_add(p, v, __ATOMIC_RELAXED, __HIP_MEMORY_SCOPE_AGENT); }
__device__ __forceinline__ unsigned xb_xcc_id() { return (unsigned)__builtin_amdgcn_s_getreg((3 << 11) | 20) & 0xFu; }
#define XB_SPIN(cond, bar) do { unsigned _sp = 0; while (cond) { __builtin_amdgcn_s_sleep(1); \
    if ((++_sp & 255u) == 0u) { if (xb_ld(&(bar)[XB_TMO])) break; if (_sp > XB_SPIN_CAP) { atomicAdd(&(bar)[XB_TMO], 1u); break; } } } } while (0)
struct XcdBarrier { unsigned* bar; unsigned x; volatile LAS unsigned* st; };
__device__ __forceinline__ XcdBarrier xcd_barrier_post(unsigned* bar, volatile LAS unsigned* st) {
    XcdBarrier b; b.bar = bar; b.x = xb_xcc_id(); b.st = st;
    if (threadIdx.x == 0) (void)xb_add(&bar[XB_XCNT(b.x)], 1u);
    return b;
}
__device__ __forceinline__ void xcd_barrier_complete(unsigned* bar, unsigned x, unsigned& nloc, unsigned& nx) {
    const unsigned G = gridDim.x * gridDim.y * gridDim.z;
    unsigned sum, cnt, mine, sp = 0u;
    for (;;) {
        sum = 0u; cnt = 0u; mine = 0u;
#pragma unroll
        for (unsigned j = 0; j < 16; ++j) { const unsigned c = xb_ld(&bar[XB_XCNT(j)]); sum += c; cnt += (c > 0u) ? 1u : 0u; mine = (j == x) ? c : mine; }
        if (sum == G) break;
        __builtin_amdgcn_s_sleep(1);
        if ((++sp & 255u) == 0u) { if (xb_ld(&bar[XB_TMO])) break; if (sp > XB_SPIN_CAP) { atomicAdd(&bar[XB_TMO], 1u); break; } }
    }
    nloc = mine > 0u ? mine : 1u; nx = cnt > 0u ? cnt : 1u;
}
__device__ __forceinline__ void xcd_barrier(const XcdBarrier& b) {
    asm volatile("s_waitcnt vmcnt(0)" ::: "memory");
    __syncthreads();
    if (threadIdx.x == 0) {
        unsigned* bar = b.bar;
        __builtin_amdgcn_s_waitcnt(0);
        unsigned nloc = b.st[0], nx = b.st[1];
        if (nloc == 0u) { xcd_barrier_complete(bar, b.x, nloc, nx); b.st[0] = nloc; b.st[1] = nx; }
        const unsigned old = xb_add(&bar[XB_XSUB(b.x)], 1u);
        const unsigned gen = old / nloc;
        if (old + 1u == (gen + 1u) * nloc) {
            __builtin_amdgcn_fence(__ATOMIC_RELEASE, "agent");
            asm volatile("s_waitcnt vmcnt(0)" ::: "memory");
            const unsigned og = xb_add(&bar[XB_TOP], 1u);
            const unsigned tg = og / nx;
            if (og + 1u == (tg + 1u) * nx) xb_add(&bar[XB_TOPGEN], 1u);
            else XB_SPIN(xb_ld(&bar[XB_TOPGEN]) == tg, bar);
            __builtin_amdgcn_fence(__ATOMIC_ACQUIRE, "agent");
            xb_add(&bar[XB_XGEN(b.x)], 1u);
            asm volatile("s_waitcnt vmcnt(0)" ::: "memory");
        } else {
            __builtin_amdgcn_fence(__ATOMIC_ACQUIRE, "agent");
            asm volatile("s_waitcnt vmcnt(0)" ::: "memory");
            XB_SPIN(xb_ld(&bar[XB_XGEN(b.x)]) == gen, bar);
        }
    }
    __syncthreads();
}

template <int MODE>
__device__ __forceinline__ void p0_transpose_item(const float* W, int K, int N, bf16* WT, const float* kscale, LAS float* scr, int item, int lane, int dst_n0, float gscale = 1.0f) {
    const int nblk = N / 32, kb = item / nblk, nb = item % nblk, k0 = 64 * kb, n0 = 32 * nb;
    {   float wv[32], sv[32];
#pragma unroll
        for (int i = 0; i < 32; ++i) { const int kk = 2 * i + (lane >> 5); wv[i] = __builtin_nontemporal_load(W + (size_t)(k0 + kk) * N + n0 + (lane & 31)); sv[i] = kscale ? kscale[k0 + kk] : 1.0f; }
        __builtin_amdgcn_sched_barrier(0);
#pragma unroll
        for (int i = 0; i < 32; ++i) { const int kk = 2 * i + (lane >> 5); scr[kk * 33 + (lane & 31)] = wv[i] * sv[i] * gscale; }
    }
    LDS_WAIT(); asm volatile("" ::: "memory");
    const int c = lane & 7;
#pragma unroll
    for (int j = 0; j < 4; ++j) { const int n = (lane >> 3) + 8 * j; const LAS float* sp = scr + (8 * c) * 33 + n;
        v4u o; o.x = pk2(sp[0 * 33], sp[1 * 33]); o.y = pk2(sp[2 * 33], sp[3 * 33]); o.z = pk2(sp[4 * 33], sp[5 * 33]); o.w = pk2(sp[6 * 33], sp[7 * 33]);
        const int nn = dst_n0 + n, kk = k0 + 8 * c;
        if (MODE == 3 || MODE == 4) {
            const int NTT = MODE == 3 ? 8 : 2, slab = MODE == 3 ? nn >> 7 : nn >> 5, cw = MODE == 3 ? nn & 127 : nn & 31, rem = cw & 31;
            const int nt = 2 * (cw >> 5) + ((rem >> 2) & 1), ln = 4 * (rem >> 3) + (rem & 3);
            { bf16* wp_ = WT + ((size_t)(((slab * 32 + (kk >> 5)) * NTT + nt) * 64 + (((kk >> 3) & 3) * 16 + ln))) * 8; ST_WT128(wp_, o); } }
        else if (MODE == 1) { bf16* wp_ = WT + ((size_t)((((nn >> 7) * 32 + (kk >> 5)) * 8 + ((nn >> 4) & 7)) * 64 + (((kk >> 3) & 3) * 16 + (nn & 15)))) * 8; ST_WT128(wp_, o); }
        else if (MODE == 2) *(v4u*)(WT + ((size_t)((((nn >> 5) * 32 + (kk >> 5)) * 2 + ((nn >> 4) & 1)) * 64 + (((kk >> 3) & 3) * 16 + (nn & 15)))) * 8) = o;
        else { bf16* wp_ = WT + (size_t)nn * K + kk; ST_WT128(wp_, o); } }
    LDS_WAIT(); asm volatile("" ::: "memory");
}
template <int NR>
__device__ __forceinline__ void p0_rows(const float* const (&xrow)[NR], bf16* const (&orow)[NR], float* const (&rs)[NR], int lane) {
    f32x4 v[NR][4];
#pragma unroll
    for (int r = 0; r < NR; ++r)
#pragma unroll
        for (int j = 0; j < 4; ++j) v[r][j] = ((const f32x4*)xrow[r])[lane + 64 * j];
    __builtin_amdgcn_sched_barrier(0);
#pragma unroll
    for (int r = 0; r < NR; ++r) { float s = 0.f;
#pragma unroll
        for (int j = 0; j < 4; ++j) s += (v[r][j].x * v[r][j].x + v[r][j].y * v[r][j].y) + (v[r][j].z * v[r][j].z + v[r][j].w * v[r][j].w);
        s = wave_sum(s);
        if (lane == 0) __hip_atomic_store(rs[r], rsqrtf(s * (1.0f / DM) + EPS), __ATOMIC_RELAXED, __HIP_MEMORY_SCOPE_AGENT);
        unsigned long long* o8 = (unsigned long long*)orow[r] + lane;
#pragma unroll
        for (int j = 0; j < 4; ++j) __hip_atomic_store(o8 + 64 * j, (unsigned long long)pk2(v[r][j].x, v[r][j].y) | ((unsigned long long)pk2(v[r][j].z, v[r][j].w) << 32), __ATOMIC_RELAXED, __HIP_MEMORY_SCOPE_AGENT); }
}

typedef _Float16 f16;
struct RgArgs { const bf16* XR; const bf16* SGR; const bf16* WG; const float* conv_w; const float* conv_b; const float* b_a; const float* b_x; const float* lam; float* AGG; unsigned* UV; };
constexpr int XCB_STRIDE = 1040;
constexpr int ZS = 516;
constexpr int RG_XCB = 0, RG_ZR = 16 * XCB_STRIDE, RG_ZI = RG_ZR + 16 * ZS * 4, RG_LDS = RG_ZI + 16 * ZS * 4;
static_assert(RG_LDS <= 100 * 1024, "rg lds");
__device__ __forceinline__ void rglru_unit(LAS unsigned char* lds, const RgArgs& R, int b, int c) {
    int tid = threadIdx.x; asm volatile("" : "+v"(tid));
    const int ch = tid, lane = tid & 63, w = __builtin_amdgcn_readfirstlane(tid >> 6);
    const size_t row0 = (size_t)b * SEQ + 64 * c;
    bf16x8 bw[2][4][2];
#pragma unroll
    for (int g = 0; g < 2; ++g)
#pragma unroll
        for (int nt = 0; nt < 4; ++nt)
#pragma unroll
            for (int ks = 0; ks < 2; ++ks) bw[g][nt][ks] = *(const bf16x8*)(R.WG + ((size_t)((w * 2 + g) * 64 + nt * 16 + (lane & 15))) * 64 + ks * 32 + 8 * (lane >> 4));
    const float cb = R.conv_b[ch], w0 = R.conv_w[ch], w1 = R.conv_w[512 + ch], w2 = R.conv_w[1024 + ch], w3 = R.conv_w[1536 + ch];
    const float ba = -LOG2E * R.b_a[ch], bxb = -LOG2E * R.b_x[ch];
    const float c2 = -8.0f * softplus_neg(R.lam[ch]) * LOG2E;
    float h = 0.f, acum = 1.0f;
    const bf16* xp = R.XR + row0 * 512 + ch;
    float xm3 = 0.f, xm2 = 0.f, xm1 = 0.f;
    if (c > 0) { xm3 = bf2f(xp[-3 * 512]); xm2 = bf2f(xp[-2 * 512]); xm1 = bf2f(xp[-1 * 512]); }
    unsigned xs[16], sg[16];
    const bf16* sp = R.SGR + row0 * 512 + ch;
#pragma unroll
    for (int i = 0; i < 16; ++i) { xs[i] = xp[i * 512]; sg[i] = sp[i * 512]; }
    __builtin_amdgcn_sched_barrier(0);
    LAS unsigned char* xcb = lds + RG_XCB; LAS float* zr = (LAS float*)(lds + RG_ZR); LAS float* zi = (LAS float*)(lds + RG_ZI);
    unsigned* uvp = R.UV + row0 * 512 + ch;
#pragma unroll 1
    for (int s = 0; s < 4; ++s) {
        unsigned xn[16], sn[16];
        { const int s1 = s < 3 ? s + 1 : 3;
#pragma unroll
            for (int i = 0; i < 16; ++i) { xn[i] = xp[(16 * s1 + i) * 512]; sn[i] = sp[(16 * s1 + i) * 512]; } }
        float xc[16];
#pragma unroll
        for (int i = 0; i < 16; ++i) { const float x = __uint_as_float(xs[i] << 16); xc[i] = cb + w0 * xm3 + w1 * xm2 + w2 * xm1 + w3 * x; xm3 = xm2; xm2 = xm1; xm1 = x;
            *(LAS bf16*)(xcb + i * XCB_STRIDE + ch * 2) = (bf16)pg8::cvt_pk_bf16(xc[i], 0.f); }
        LDS_WAIT(); __builtin_amdgcn_wave_barrier();
        {
            bf16x8 af[2];
#pragma unroll
            for (int ks = 0; ks < 2; ++ks) af[ks] = *(const LAS bf16x8*)(xcb + (lane & 15) * XCB_STRIDE + (64 * w + 32 * ks + 8 * (lane >> 4)) * 2);
#pragma unroll
            for (int g = 0; g < 2; ++g)
#pragma unroll
                for (int nt = 0; nt < 4; ++nt) { f32x4 acc = {0.f, 0.f, 0.f, 0.f};
#pragma unroll
                    for (int ks = 0; ks < 2; ++ks) acc = __builtin_amdgcn_mfma_f32_16x16x32_bf16(af[ks], bw[g][nt][ks], acc, 0, 0, 0);
                    LAS float* z = g ? zi : zr;
#pragma unroll
                    for (int r = 0; r < 4; ++r) z[(4 * (lane >> 4) + r) * ZS + 64 * w + 16 * nt + (lane & 15)] = acc[r]; }
        }
        LDS_WAIT(); __builtin_amdgcn_wave_barrier();
        typedef float f32x2 __attribute__((ext_vector_type(2)));
#pragma unroll
        for (int i = 0; i < 16; i += 2) {
            const f32x2 zrv = {zr[i * ZS + ch], zr[(i + 1) * ZS + ch]}, ziv = {zi[i * ZS + ch], zi[(i + 1) * ZS + ch]};
            const f32x2 er = zrv + ba, ei = ziv + bxb;
            f32x2 dr = {ex2(er.x), ex2(er.y)}, di = {ex2(ei.x), ex2(ei.y)};
            dr = dr + 1.0f; di = di + 1.0f;
            const f32x2 r = {rcpf_(dr.x), rcpf_(dr.y)}, ig = {rcpf_(di.x), rcpf_(di.y)};
            const f32x2 l2 = r * c2;
            const f32x2 a = {ex2(l2.x), ex2(l2.y)};
            const f32x2 x2 = l2 * 1.3862943611198906f;
            const f32x2 em_small = -x2 * ((x2 * 0.16666667f + 0.5f) * x2 + 1.0f);
            const f32x2 em_big = 1.0f - a * a;
            const f32x2 em = {(x2.x > -0.015625f) ? em_small.x : em_big.x, (x2.y > -0.015625f) ? em_small.y : em_big.y};
            const f32x2 sq = {__builtin_amdgcn_sqrtf(em.x), __builtin_amdgcn_sqrtf(em.y)};
            const f32x2 xcv = {xc[i], xc[i + 1]};
            const f32x2 bx = sq * (ig * xcv);
            const float h0 = __builtin_fmaf(a.x, h, bx.x), h1 = __builtin_fmaf(a.y, h0, bx.y);
            const float ac0 = acum * a.x, ac1 = ac0 * a.y;
            h = h1; acum = ac1;
            const f32x2 sgv = {__uint_as_float(sg[i] << 16), __uint_as_float(sg[i + 1] << 16)};
            const f32x2 uu = sgv * (f32x2){h0, h1}, vv2 = sgv * (f32x2){ac0, ac1};
            typedef f16 f16x2 __attribute__((ext_vector_type(2)));
            const f16x2 p0 = {(f16)uu.x, (f16)vv2.x}, p1 = {(f16)uu.y, (f16)vv2.y};
            uvp[(size_t)(16 * s + i) * 512] = __builtin_bit_cast(unsigned, p0);
            uvp[(size_t)(16 * s + i + 1) * 512] = __builtin_bit_cast(unsigned, p1);
        }
#pragma unroll
        for (int i = 0; i < 16; ++i) { xs[i] = xn[i]; sg[i] = sn[i]; }
    }
    { float* ag = R.AGG + ((size_t)b * NCHUNK + c) * 1024 + ch;
      __hip_atomic_store(ag, acum, __ATOMIC_RELAXED, __HIP_MEMORY_SCOPE_AGENT); __hip_atomic_store(ag + 512, h, __ATOMIC_RELAXED, __HIP_MEMORY_SCOPE_AGENT); }
    VM_WAIT(); __syncthreads();
}

typedef float f32x16 __attribute__((ext_vector_type(16)));
constexpr int AT_K = 0, AT_KS = 144, AT_NK = 192, AT_VT = 2 * AT_NK * AT_KS, AT_VS = 392, AT_T = AT_VT + 2 * 64 * AT_VS, AT_LDS = AT_T + 8 * 384 * 4;
static_assert(AT_LDS <= 144384, "attention lds");
__device__ __forceinline__ unsigned cvtpk(float lo, float hi) { unsigned r; asm volatile("v_cvt_pk_bf16_f32 %0, %1, %2" : "=v"(r) : "v"(lo), "v"(hi)); return r; }
__device__ __forceinline__ void attn_table(LAS unsigned char* lds, const float* rel_bias) {
    LAS float* T = (LAS float*)(lds + AT_T);
    for (int e = threadIdx.x; e < 8 * 384; e += 512) { const int hl = e / 384, ti = e - hl * 384; float v = -1e30f; if (ti >= 128 && ti <= 255) v = rel_bias[t5_bucket(255 - ti) * NH + hl] * LOG2E; T[e] = v; }
}
__device__ __forceinline__ void attn_unit(LAS unsigned char* lds, int b, int c, const bf16* Q, const bf16* KV, const bf16* SGA, const float* sinks, const float* rel_bias, bf16* MIX, bool build_T, bool to_lds) {
    int tid = threadIdx.x; asm volatile("" : "+v"(tid));
    const int lane = tid & 63, w = __builtin_amdgcn_readfirstlane(tid >> 6), r32 = lane & 31, hi = lane >> 5;
    const int n = c >> 1, half = c & 1, kt0 = 2 * half, h = w, g = w >> 2;
    const size_t rowblk = (size_t)b * SEQ + 128 * n;
    LAS float* T = (LAS float*)(lds + AT_T);
    {   v4u kk[6], vv[6];
#pragma unroll
        for (int i = 0; i < 6; ++i) { const int e = tid + 512 * i, key = e >> 4, gq = (e >> 3) & 1, cc = e & 7;
            const int kb = 32 * kt0 + key;
            const int ksrc = (n > 0 || kb >= 128) ? kb : kb + 128;
            const bf16* kr = KV + (rowblk - 128 + ksrc) * 256 + gq * 64 + cc * 8;
            kk[i] = *(const v4u*)kr; vv[i] = *(const v4u*)(kr + 128); }
        __builtin_amdgcn_sched_barrier(0);
#pragma unroll
        for (int i = 0; i < 6; ++i) { const int e = tid + 512 * i, key = e >> 4, gq = (e >> 3) & 1, cc = e & 7;
            *(LAS v4u*)(lds + AT_K + (gq * AT_NK + key) * AT_KS + cc * 16) = kk[i];
#pragma unroll
            for (int j = 0; j < 8; ++j) *(LAS bf16*)(lds + AT_VT + (gq * 64 + cc * 8 + j) * AT_VS + key * 2) = (bf16)((vv[i][j >> 1] >> (16 * (j & 1))) & 0xffffu); }
    }
    if (build_T) attn_table(lds, rel_bias);
    LDS_WAIT(); __syncthreads();
    const float sinkv = sinks[h] * LOG2E;
    v2u ovs[2][4];
#pragma unroll 1
    for (int i = 0; i < 2; ++i) {
        const int qt = kt0 + i; const size_t qrow = rowblk + 32 * qt + r32;
        bf16x8 qf[4];
#pragma unroll
        for (int ks = 0; ks < 4; ++ks) qf[ks] = *(const bf16x8*)(Q + qrow * 512 + h * 64 + 16 * ks + 8 * hi);
        v2u sgv[2][4];
#pragma unroll
        for (int dt = 0; dt < 2; ++dt)
#pragma unroll
            for (int i4 = 0; i4 < 4; ++i4) sgv[dt][i4] = *(const v2u*)(SGA + qrow * 512 + h * 64 + 32 * dt + 8 * i4 + 4 * hi);
        f32x16 s[5];
#pragma unroll
        for (int j = 0; j < 5; ++j) {
            const int kt = qt + j, ktl = i + j;
            if (n == 0 && kt < 4) {
#pragma unroll
                for (int r = 0; r < 16; ++r) s[j][r] = -1e30f;
            } else {
                const LAS float* tp = T + h * 384 + (32 * kt + 4 * hi - 32 * qt - r32 + 127);
#pragma unroll
                for (int r = 0; r < 16; ++r) s[j][r] = tp[(r & 3) + 8 * (r >> 2)];
                const LAS unsigned char* kp = lds + AT_K + (g * AT_NK + 32 * ktl + r32) * AT_KS + 16 * hi;
#pragma unroll
                for (int ks = 0; ks < 4; ++ks) { const bf16x8 kf = *(const LAS bf16x8*)(kp + 32 * ks); s[j] = __builtin_amdgcn_mfma_f32_32x32x16_bf16(kf, qf[ks], s[j], 0, 0, 0); }
            }
        }
        float m = sinkv;
#pragma unroll
        for (int j = 0; j < 5; ++j)
#pragma unroll
            for (int r = 0; r < 16; ++r) m = fmaxf(m, s[j][r]);
        { auto rr = __builtin_amdgcn_permlane32_swap(__float_as_uint(m), __float_as_uint(m), false, false); m = fmaxf(__uint_as_float(rr[0]), __uint_as_float(rr[1])); }
        float l = 0.f;
#pragma unroll
        for (int j = 0; j < 5; ++j)
#pragma unroll
            for (int r = 0; r < 16; ++r) { const float p = ex2(s[j][r] - m); s[j][r] = p; l += p; }
        { auto rr = __builtin_amdgcn_permlane32_swap(__float_as_uint(l), __float_as_uint(l), false, false); l = __uint_as_float(rr[0]) + __uint_as_float(rr[1]); }
        l += ex2(sinkv - m);
        f32x16 o[2];
#pragma unroll
        for (int r = 0; r < 16; ++r) { o[0][r] = 0.f; o[1][r] = 0.f; }
#pragma unroll
        for (int j = 0; j < 5; ++j) {
            const int kt = qt + j, ktl = i + j;
            if (!(n == 0 && kt < 4)) {
#pragma unroll
                for (int s2 = 0; s2 < 2; ++s2) {
                    v4u pw; pw.x = cvtpk(s[j][8 * s2 + 0], s[j][8 * s2 + 1]); pw.y = cvtpk(s[j][8 * s2 + 2], s[j][8 * s2 + 3]); pw.z = cvtpk(s[j][8 * s2 + 4], s[j][8 * s2 + 5]); pw.w = cvtpk(s[j][8 * s2 + 6], s[j][8 * s2 + 7]);
                    const bf16x8 pf = __builtin_bit_cast(bf16x8, pw);
#pragma unroll
                    for (int dt = 0; dt < 2; ++dt) {
                        const LAS unsigned char* vp = lds + AT_VT + (g * 64 + 32 * dt + r32) * AT_VS + (32 * ktl + 16 * s2 + 4 * hi) * 2;
                        const v2u vlo = *(const LAS v2u*)vp, vhi = *(const LAS v2u*)(vp + 16);
                        v4u vw; vw.x = vlo.x; vw.y = vlo.y; vw.z = vhi.x; vw.w = vhi.y;
                        o[dt] = __builtin_amdgcn_mfma_f32_32x32x16_bf16(__builtin_bit_cast(bf16x8, vw), pf, o[dt], 0, 0, 0);
                    }
                }
            }
        }
        const float il = 1.0f / l;
#pragma unroll
        for (int dt = 0; dt < 2; ++dt)
#pragma unroll
            for (int i4 = 0; i4 < 4; ++i4) { const int d0 = 32 * dt + 8 * i4 + 4 * hi; const v2u sg = sgv[dt][i4];
                const float a0 = o[dt][4 * i4 + 0] * il * __uint_as_float(sg.x << 16), a1 = o[dt][4 * i4 + 1] * il * __uint_as_float(sg.x & 0xffff0000u);
                const float a2 = o[dt][4 * i4 + 2] * il * __uint_as_float(sg.y << 16), a3 = o[dt][4 * i4 + 3] * il * __uint_as_float(sg.y & 0xffff0000u);
                v2u ov; ov.x = cvtpk(a0, a1); ov.y = cvtpk(a2, a3);
                ovs[dt][i4] = ov;
                if (!to_lds) *(v2u*)(MIX + qrow * 512 + h * 64 + d0) = ov;
                else if (i == 0) *(LAS v2u*)(lds + AT_LDS + r32 * A_STRIDE + (h * 64 + d0) * 2) = ov; }
    }
    __syncthreads();
    if (to_lds) {
#pragma unroll
        for (int dt = 0; dt < 2; ++dt)
#pragma unroll
            for (int i4 = 0; i4 < 4; ++i4) *(LAS v2u*)(lds + A_ATT + (32 + r32) * A_STRIDE + (h * 64 + 32 * dt + 8 * i4 + 4 * hi) * 2) = ovs[dt][i4];
#pragma unroll
        for (int i = 0; i < 4; ++i) { const int e = tid + 512 * i, r = e >> 6, cc = e & 63;
            *(LAS v4u*)(lds + A_ATT + r * A_STRIDE + cc * 16) = *(const LAS v4u*)(lds + AT_LDS + r * A_STRIDE + cc * 16); }
        LDS_WAIT(); __syncthreads();
    }
}

struct SmpArgs { const bf16 *XR, *SGR, *Q, *KV, *SGA, *WG; const float *state_conv, *state_rnn, *ck, *cv, *conv_w, *conv_b, *b_a, *b_x, *lam, *sinks; bf16* MIX; float* out; };
constexpr int SM_XC = 0, SM_QS = 1024, SM_PS = 2048, SM_XB = 4096, SM_ZS = 4608, SM_KS = 8192, SM_VS = SM_KS + 128 * 65 * 4, SM_LDS = SM_VS + 128 * 64 * 4;
constexpr int BTAB_OFF = 144384;
static_assert(SM_ZS + 2048 <= SM_KS && SM_LDS <= BTAB_OFF && BTAB_OFF + 4096 <= LDSCTL_OFF, "sample lds");
__device__ __forceinline__ void st_wt16(bf16* p, unsigned v) { __hip_atomic_store(p, (bf16)v, __ATOMIC_RELAXED, __HIP_MEMORY_SCOPE_AGENT); }
struct SmpPre { f32x4 kk[4], vv[4]; };
__device__ __forceinline__ void sample_prefetch(SmpPre& p, const float* ck, const float* cv, int b, int g, int tid) {
    const float* ckb = ck + (size_t)b * 16384 + 128 + g * 64; const float* cvb = cv + (size_t)b * 16384 + 128 + g * 64;
#pragma unroll
    for (int i = 0; i < 4; ++i) { const int e0 = tid + 512 * i, e = e0 < 127 * 16 ? e0 : 127 * 16 - 1; const int ww = e >> 4, d = (e & 15) * 4; p.kk[i] = __builtin_nontemporal_load((const f32x4*)(ckb + ww * 128 + d)); p.vv[i] = __builtin_nontemporal_load((const f32x4*)(cvb + ww * 128 + d)); }
}
template <bool PRE>
__device__ __forceinline__ void sample_unit(LAS unsigned char* lds, const LAS float* btab, const SmpArgs& S, int b, int g, unsigned* cnt, const SmpPre& pre) {
    LAS float* xc = (LAS float*)(lds + SM_XC); LAS float* qs = (LAS float*)(lds + SM_QS); LAS float* ps = (LAS float*)(lds + SM_PS); LAS float* Ks = (LAS float*)(lds + SM_KS); LAS float* Vs = (LAS float*)(lds + SM_VS);
    LAS float* zs = (LAS float*)(lds + SM_ZS);
    int tid = threadIdx.x; asm volatile("" : "+v"(tid));
    const int lane = tid & 63, w = __builtin_amdgcn_readfirstlane(tid >> 6);
    const size_t r = (size_t)(MP + b);
    const int t8 = tid & 255, ch = 256 * g + t8;
    const float* ckb = S.ck + (size_t)b * 16384 + 128 + g * 64; const float* cvb = S.cv + (size_t)b * 16384 + 128 + g * 64;
    f32x4 kk[4], vv[4];
    if (PRE) {
#pragma unroll
        for (int i = 0; i < 4; ++i) { kk[i] = pre.kk[i]; vv[i] = pre.vv[i]; }
    } else {
#pragma unroll
        for (int i = 0; i < 4; ++i) { const int e0 = tid + 512 * i, e = e0 < 127 * 16 ? e0 : 127 * 16 - 1; const int ww = e >> 4, d = (e & 15) * 4; kk[i] = __builtin_nontemporal_load((const f32x4*)(ckb + ww * 128 + d)); vv[i] = __builtin_nontemporal_load((const f32x4*)(cvb + ww * 128 + d)); }
    }
    const unsigned x0u = S.XR[r * 512 + ch], qu = S.Q[r * 512 + ch], sgru = S.SGR[r * 512 + ch], sgau = S.SGA[r * 512 + ch];
    const unsigned knu = S.KV[r * 256 + g * 64 + (tid & 63)], vnu = S.KV[r * 256 + 128 + g * 64 + (tid & 63)];
    const float s0 = S.state_conv[(size_t)(b * 3 + 0) * 512 + ch], s1 = S.state_conv[(size_t)(b * 3 + 1) * 512 + ch], s2 = S.state_conv[(size_t)(b * 3 + 2) * 512 + ch];
    const float cw0 = S.conv_w[ch], cw1 = S.conv_w[512 + ch], cw2 = S.conv_w[1024 + ch], cw3 = S.conv_w[1536 + ch], cbv = S.conv_b[ch];
    const float bav = S.b_a[ch], bxv = S.b_x[ch], lamv = S.lam[ch], h0 = S.state_rnn[(size_t)b * 512 + ch];
    const float skv = S.sinks[4 * g + (w & 3)];
    bf16x8 bw[2][4][2];
    { const int nb = 4 * g + (w & 3);
#pragma unroll
      for (int gg = 0; gg < 2; ++gg)
#pragma unroll
        for (int nt = 0; nt < 4; ++nt)
#pragma unroll
            for (int ks = 0; ks < 2; ++ks) bw[gg][nt][ks] = *(const bf16x8*)(S.WG + ((size_t)((nb * 2 + gg) * 64 + nt * 16 + (lane & 15))) * 64 + ks * 32 + 8 * (lane >> 4)); }
    __builtin_amdgcn_sched_barrier(0);
    const float x0 = __uint_as_float(x0u << 16);
    const float xcv = cbv + cw0 * s0 + cw1 * s1 + cw2 * s2 + cw3 * x0;
    if (tid < 256) { xc[t8] = xcv; *(LAS bf16*)(lds + SM_XB + t8 * 2) = (bf16)pg8::cvt_pk_bf16(xcv, 0.f); qs[t8] = __uint_as_float(qu << 16);
        S.out[O_CS + (size_t)(b * 3 + 0) * 512 + ch] = s1; S.out[O_CS + (size_t)(b * 3 + 1) * 512 + ch] = s2; }
    else if (tid < 320) { Ks[127 * 65 + lane] = __uint_as_float(knu << 16); Vs[127 * 64 + lane] = __uint_as_float(vnu << 16); }
#pragma unroll
    for (int i = 0; i < 4; ++i) { const int e = tid + 512 * i; if (e < 127 * 16) { const int ww = e >> 4, d = (e & 15) * 4;
        LAS float* kd = Ks + ww * 65 + d; kd[0] = kk[i].x; kd[1] = kk[i].y; kd[2] = kk[i].z; kd[3] = kk[i].w; *(LAS f32x4*)(Vs + ww * 64 + d) = vv[i]; } }
    __syncthreads();    if (tid < 256) {
        bf16x8 af[2];
#pragma unroll
        for (int ks = 0; ks < 2; ++ks) af[ks] = *(const LAS bf16x8*)(lds + SM_XB + (64 * w + 32 * ks + 8 * (lane >> 4)) * 2);
#pragma unroll
        for (int gg = 0; gg < 2; ++gg)
#pragma unroll
            for (int nt = 0; nt < 4; ++nt) { f32x4 acc = {0.f, 0.f, 0.f, 0.f};
#pragma unroll
                for (int ks = 0; ks < 2; ++ks) acc = __builtin_amdgcn_mfma_f32_16x16x32_bf16(af[ks], bw[gg][nt][ks], acc, 0, 0, 0);
                if (lane < 16) zs[gg * 256 + 64 * w + 16 * nt + lane] = acc[0]; }
        LDS_WAIT(); __builtin_amdgcn_wave_barrier();
        const float rr = rcpf_(1.0f + ex2(zs[t8] - LOG2E * bav)), ig = rcpf_(1.0f + ex2(zs[256 + t8] - LOG2E * bxv));
        const float l2 = rr * (-8.0f * softplus_neg(lamv) * LOG2E); const float a = ex2(l2);
        const float x2 = 1.3862943611198906f * l2;
        const float em_small = -x2 * __builtin_fmaf(__builtin_fmaf(x2, 0.16666667f, 0.5f), x2, 1.0f);
        const float em = (x2 > -0.015625f) ? em_small : __builtin_fmaf(-a, a, 1.0f);
        const float h = a * h0 + __builtin_amdgcn_sqrtf(em) * (ig * xcv);
        S.out[O_RS + (size_t)b * 512 + ch] = h;
        st_wt16(S.MIX + r * DM + ch, pg8::cvt_pk_bf16(h * __uint_as_float(sgru << 16), 0.f));
    }
    {
        const int hh = tid >> 7, ww = tid & 127;
        const LAS float* kp = Ks + ww * 65; const LAS float* qp = qs + hh * 64;
        float sc = 0.f;
#pragma unroll 16
        for (int d = 0; d < 64; ++d) sc += qp[d] * kp[d];
        ps[hh * 128 + ww] = sc + btab[(4 * g + hh) * 128 + 127 - ww];
    }
    __syncthreads();    if (tid < 256) {
        const float sa = ps[w * 128 + lane], sb = ps[w * 128 + 64 + lane];
        const float sk = skv * LOG2E;
        float m = fmaxf(fmaxf(sa, sb), sk);
#pragma unroll
        for (int o2 = 32; o2 > 0; o2 >>= 1) m = fmaxf(m, __shfl_xor(m, o2));
        const float p0 = ex2(sa - m), p1 = ex2(sb - m);
        const float l = wave_sum(p0 + p1) + ex2(sk - m);
        const float il = 1.0f / l;
        ps[w * 128 + lane] = p0 * il; ps[w * 128 + 64 + lane] = p1 * il;
        LDS_WAIT(); __builtin_amdgcn_wave_barrier();
        const LAS float* vp = Vs + lane; const LAS float* pp = ps + w * 128;
        float o = 0.f;
#pragma unroll 16
        for (int k = 0; k < 128; ++k) o += pp[k] * vp[k * 64];
        st_wt16(S.MIX + r * DM + 512 + ch, pg8::cvt_pk_bf16(o * __uint_as_float(sgau << 16), 0.f));
    }
    VM_WAIT(); __syncthreads();    if (tid == 0) __hip_atomic_fetch_add(cnt, 1u, __ATOMIC_RELAXED, __HIP_MEMORY_SCOPE_AGENT);
    {
        float* okb = S.out + O_KS + (size_t)b * 16384 + g * 64; float* ovb = S.out + O_VS + (size_t)b * 16384 + g * 64;
#pragma unroll
        for (int i = 0; i < 4; ++i) { const int e = tid + 512 * i; if (e < 127 * 16) { const int ww = e >> 4, d = (e & 15) * 4; __builtin_nontemporal_store(kk[i], (f32x4*)(okb + ww * 128 + d)); __builtin_nontemporal_store(vv[i], (f32x4*)(ovb + ww * 128 + d)); } }
    }
}

template <int NLOADS>
__device__ __forceinline__ unsigned l2_warm_issue(v4u (&pf)[NLOADS], const void* base, int tid) {
    const char* p = (const char*)base + ((size_t)(((blockIdx.x >> 3) & 31) * 8 + (tid >> 6)) * NLOADS) * 1024 + (tid & 63) * 16;
#pragma unroll
    for (int i = 0; i < NLOADS; ++i) pf[i] = *(const v4u*)(p + i * 1024);
    return 0u;
}
template <int NLOADS>
__device__ __forceinline__ void l2_warm_retire(const v4u (&pf)[NLOADS], unsigned* sink) {
    unsigned a = 0u;
#pragma unroll
    for (int i = 0; i < NLOADS; ++i) a |= pf[i].x ^ pf[i].y ^ pf[i].z ^ pf[i].w;
    if (a == 0x9E3779B9u && threadIdx.x == 12345) *sink = a;
}
constexpr int A_LO = A_RNN, A_HI = A_ATT, A_RS = A_PART;
struct ProjArgs { const float* x; const bf16 *WA, *WB, *WKV; bf16 *XR, *SGR, *Q, *SGA, *KV; float* out; unsigned* sink; bf16* XB2; };
#define AS_LOADB(dst, wfp, NTT, ks) do { _Pragma("unroll") for (int nt = 0; nt < NTT; ++nt) dst[nt] = *(const bf16x8*)((wfp) + (size_t)(((ks) * NTT + nt) * 512)); } while (0)
#define AS_STEP(accv, bw, NTT, ks) do { bf16x8 af[4]; const LAS unsigned char* ap = abase + (((ks) < 16) ? A_LO : A_HI) + (((ks) & 15) * 64); \
        _Pragma("unroll") for (int mt = 0; mt < 4; ++mt) af[mt] = *(const LAS bf16x8*)(ap + mt * 16 * A_STRIDE); \
        _Pragma("unroll") for (int mt = 0; mt < 4; ++mt) _Pragma("unroll") for (int nt = 0; nt < NTT; ++nt) accv[mt][nt] = __builtin_amdgcn_mfma_f32_16x16x32_bf16(bw[nt], af[mt], accv[mt][nt], 0, 0, 0); } while (0)
__device__ __forceinline__ v4u pack8(f32x4 a, f32x4 b) { v4u o; o.x = pg8::cvt_pk_bf16(a.x, a.y); o.y = pg8::cvt_pk_bf16(a.z, a.w); o.z = pg8::cvt_pk_bf16(b.x, b.y); o.w = pg8::cvt_pk_bf16(b.z, b.w); return o; }
__device__ __forceinline__ f32x4 silu4(f32x4 v) { f32x4 o; o.x = silu_(v.x); o.y = silu_(v.y); o.z = silu_(v.z); o.w = silu_(v.w); return o; }
template <int PASS>
__device__ __forceinline__ void proj_pass(const LAS unsigned char* abase, size_t row0, int w, int lane, int fr, int fq, const float (&rs)[4], const bf16* W, bf16* dlo, bf16* dhi, float* out) {
    const bf16* wf = W + (size_t)w * (32 * 8 * 64 * 8) + lane * 8;
    f32x4 acc[4][8];
#pragma unroll
    for (int mt = 0; mt < 4; ++mt)
#pragma unroll
        for (int nt = 0; nt < 8; ++nt) acc[mt][nt] = (f32x4){0.f, 0.f, 0.f, 0.f};
    bf16x8 b0[8], b1[8], b2[8];
    AS_LOADB(b0, wf, 8, 0); AS_LOADB(b1, wf, 8, 1);
#pragma unroll 1
    for (int ks = 0; ks < 30; ks += 3) {
        AS_LOADB(b2, wf, 8, ks + 2); __builtin_amdgcn_sched_barrier(0);
        AS_STEP(acc, b0, 8, ks); __builtin_amdgcn_sched_barrier(0);
        AS_LOADB(b0, wf, 8, ks + 3); __builtin_amdgcn_sched_barrier(0);
        AS_STEP(acc, b1, 8, ks + 1); __builtin_amdgcn_sched_barrier(0);
        AS_LOADB(b1, wf, 8, (ks + 4 < 32 ? ks + 4 : 31)); __builtin_amdgcn_sched_barrier(0);
        AS_STEP(acc, b2, 8, ks + 2); __builtin_amdgcn_sched_barrier(0);
    }
    AS_STEP(acc, b0, 8, 30); __builtin_amdgcn_sched_barrier(0);
    AS_STEP(acc, b1, 8, 31); __builtin_amdgcn_sched_barrier(0);
    bf16* dst = (w < 4) ? dlo : dhi;
    const int colw = 128 * (w & 3) + 8 * fq;
#pragma unroll
    for (int mt = 0; mt < 4; ++mt) { const size_t row = row0 + 16 * mt + fr;
#pragma unroll
        for (int p = 0; p < 4; ++p) { f32x4 v0 = acc[mt][2 * p] * rs[mt], v1 = acc[mt][2 * p + 1] * rs[mt];
            if (w >= 4) { v0 = silu4(v0); v1 = silu4(v1); } else if (PASS) { v0 = v0 * QSCALE; v1 = v1 * QSCALE; }
            *(v4u*)(dst + row * 512 + colw + 32 * p) = pack8(v0, v1);
            if (PASS == 0 && w < 4) { const int j = (int)(row & (SEQ - 1)) - (SEQ - 3);
                if (j >= 0) { float* o = out + O_CP + (size_t)((row >> 13) * 3 + j) * 512 + colw + 32 * p; *(f32x4*)o = v0; *(f32x4*)(o + 4) = v1; } } } }
}
__device__ __forceinline__ void proj_unit(LAS unsigned char* lds, int u, const ProjArgs& P) {
    int tid = threadIdx.x; asm volatile("" : "+v"(tid));
    const int lane = tid & 63, w = __builtin_amdgcn_readfirstlane(tid >> 6), fr = lane & 15, fq = lane >> 4;
    const size_t row0 = (size_t)u * 64;
    LAS float* rsl = (LAS float*)(lds + A_RS);
    {
        v4u pfa[8]; l2_warm_issue<8>(pfa, P.WA, tid);
        f32x4 v[8][4];
#pragma unroll
        for (int r = 0; r < 8; ++r)
#pragma unroll
            for (int j = 0; j < 4; ++j) v[r][j] = __builtin_nontemporal_load((const f32x4*)(P.x + (row0 + 8 * w + r) * DM) + lane + 64 * j);
        __builtin_amdgcn_sched_barrier(0);
#pragma unroll
        for (int r = 0; r < 8; ++r) { const int row = 8 * w + r; float s = 0.f;
#pragma unroll
            for (int j = 0; j < 4; ++j) { s += (v[r][j].x * v[r][j].x + v[r][j].y * v[r][j].y) + (v[r][j].z * v[r][j].z + v[r][j].w * v[r][j].w);
                v2u o; o.x = pg8::cvt_pk_bf16(v[r][j].x, v[r][j].y); o.y = pg8::cvt_pk_bf16(v[r][j].z, v[r][j].w);
                *(LAS v2u*)(lds + (j < 2 ? A_LO : A_HI) + row * A_STRIDE + ((4 * lane + 256 * j) & 511) * 2) = o;
                *(v2u*)(P.XB2 + (row0 + row) * DM + 4 * lane + 256 * j) = o; }
            s = wave_sum(s);
            if (lane == 0) rsl[row] = rsqrtf(s * (1.0f / DM) + EPS); }
        v4u pfb[8], pfc[2]; l2_warm_issue<8>(pfb, P.WB, tid); l2_warm_issue<2>(pfc, P.WKV, tid);
        __builtin_amdgcn_sched_barrier(0);
        l2_warm_retire<8>(pfa, P.sink); l2_warm_retire<8>(pfb, P.sink); l2_warm_retire<2>(pfc, P.sink);
    }
    LDS_WAIT(); __syncthreads();
    const LAS unsigned char* abase = lds + fr * A_STRIDE + fq * 16;
    float rs[4];
#pragma unroll
    for (int mt = 0; mt < 4; ++mt) rs[mt] = rsl[16 * mt + fr];
    proj_pass<0>(abase, row0, w, lane, fr, fq, rs, P.WA, P.XR, P.SGR, P.out);
    proj_pass<1>(abase, row0, w, lane, fr, fq, rs, P.WB, P.Q, P.SGA, P.out);
    {
        const bf16* wf = P.WKV + (size_t)w * (32 * 2 * 64 * 8) + lane * 8;
        f32x4 acc[4][2];
#pragma unroll
        for (int mt = 0; mt < 4; ++mt)
#pragma unroll
            for (int nt = 0; nt < 2; ++nt) acc[mt][nt] = (f32x4){0.f, 0.f, 0.f, 0.f};
        bf16x8 bA[8][2], bB[8][2];
#define KV_LOADB(dst, k0) do { _Pragma("unroll") for (int k = 0; k < 8; ++k) AS_LOADB(dst[k], wf, 2, (k0) + k); } while (0)
#define KV_COMPUTE(bw, k0) do { _Pragma("unroll") for (int k = 0; k < 8; ++k) AS_STEP(acc, bw[k], 2, (k0) + k); } while (0)
        KV_LOADB(bA, 0); KV_LOADB(bB, 8); __builtin_amdgcn_sched_barrier(0);
        KV_COMPUTE(bA, 0);  __builtin_amdgcn_sched_barrier(0); KV_LOADB(bA, 16); __builtin_amdgcn_sched_barrier(0);
        KV_COMPUTE(bB, 8);  __builtin_amdgcn_sched_barrier(0); KV_LOADB(bB, 24); __builtin_amdgcn_sched_barrier(0);
        KV_COMPUTE(bA, 16); __builtin_amdgcn_sched_barrier(0);
        KV_COMPUTE(bB, 24); __builtin_amdgcn_sched_barrier(0);
#undef KV_LOADB
#undef KV_COMPUTE
        const int col = 32 * w + 8 * fq;
#pragma unroll
        for (int mt = 0; mt < 4; ++mt) { const size_t row = row0 + 16 * mt + fr; const int wi = (int)(row & (SEQ - 1)) - (SEQ - WIN);
            const f32x4 v0 = acc[mt][0] * rs[mt], v1 = acc[mt][1] * rs[mt];
            *(v4u*)(P.KV + row * 256 + col) = pack8(v0, v1);
            if (wi >= 0) { float* o = P.out + (col < 128 ? O_KP : O_VP) + (size_t)((row >> 13) * WIN + wi) * 128 + (col & 127); *(f32x4*)o = v0; *(f32x4*)(o + 4) = v1; } }
    }
    __syncthreads();
}
struct SprojArgs { const bf16* XB; const bf16 *WA, *WB, *WKV; const float* RSTD; bf16 *XR, *SGR, *Q, *KV, *SGA; float* out; };
__device__ __forceinline__ void sample_proj_unit(LAS unsigned char* lds, int sl, const SprojArgs& P) {
    int tid = threadIdx.x; asm volatile("" : "+v"(tid));
    const int lane = tid & 63, w = __builtin_amdgcn_readfirstlane(tid >> 6), fr = lane & 15, fq = lane >> 4;
    const int rg = sl / 36, cg = sl % 36, pass = cg >> 4;
    const bf16* wa_ = P.WA; const bf16* wb_ = P.WB; const bf16* wkv_ = P.WKV;
    const bf16* ap = P.XB + (size_t)(MP + 32 * rg + fr) * DM + 128 * w + 8 * fq;
    bf16x8 af[2][4], bw[4][4];
#pragma unroll
    for (int j = 0; j < 4; ++j) {
        const int slab = pass < 2 ? (cg >> 1) & 7 : 2 * (cg - 32) + (j >> 1), nta = pass < 2 ? 4 * (cg & 1) + j : (j & 1), NTT = pass < 2 ? 8 : 2;
        const bf16* bp = (pass == 0 ? wa_ : pass == 1 ? wb_ : wkv_) + ((size_t)(slab * 32 * NTT + nta) * 64 + lane) * 8;
#pragma unroll
        for (int k = 0; k < 4; ++k) bw[j][k] = *(const bf16x8*)(bp + (size_t)(4 * w + k) * NTT * 512); }
#pragma unroll
    for (int mt = 0; mt < 2; ++mt)
#pragma unroll
        for (int k = 0; k < 4; ++k) af[mt][k] = *(const bf16x8*)(ap + (size_t)(16 * mt) * DM + 32 * k);
    const int tmt = w >> 2, tj = w & 3;
    const float rstd_row = P.RSTD[(size_t)MP + 32 * rg + 16 * tmt + fr];
    __builtin_amdgcn_sched_barrier(0);
    LAS float* red = (LAS float*)lds;
#pragma unroll
    for (int mt = 0; mt < 2; ++mt)
#pragma unroll
        for (int j = 0; j < 4; ++j) { f32x4 acc = {0.f, 0.f, 0.f, 0.f};
#pragma unroll
            for (int k = 0; k < 4; ++k) acc = __builtin_amdgcn_mfma_f32_16x16x32_bf16(bw[j][k], af[mt][k], acc, 0, 0, 0);
            *(LAS f32x4*)(red + ((w * 8 + mt * 4 + j) * 64 + lane) * 4) = acc; }
    LDS_WAIT(); __syncthreads();
    f32x4 v = {0.f, 0.f, 0.f, 0.f};
#pragma unroll
    for (int ww = 0; ww < 8; ++ww) v += *(const LAS f32x4*)(red + ((ww * 8 + w) * 64 + lane) * 4);
    const int b = 32 * rg + 16 * tmt + fr; const size_t row = (size_t)MP + b;
    v = v * rstd_row;
    const int slab = pass < 2 ? (cg >> 1) & 7 : 2 * (cg - 32) + (tj >> 1), nt = pass < 2 ? 4 * (cg & 1) + tj : (tj & 1);
    const int cin = 32 * (nt >> 1) + 8 * fq + 4 * (nt & 1);
    v2u o;
    if (pass < 2) { const int col = 128 * (slab & 3) + cin;
        if (slab >= 4) v = silu4(v); else if (pass) v = v * QSCALE;
        o.x = pg8::cvt_pk_bf16(v.x, v.y); o.y = pg8::cvt_pk_bf16(v.z, v.w);
        bf16* q_ = P.Q; bf16* sga_ = P.SGA; bf16* xr_ = P.XR; bf16* sgr_ = P.SGR;
        bf16* dst = pass ? (slab < 4 ? q_ : sga_) : (slab < 4 ? xr_ : sgr_);
        *(v2u*)(dst + row * 512 + col) = o;
        if (pass == 0 && slab < 4) *(f32x4*)(P.out + O_CS + (size_t)(b * 3 + 2) * 512 + col) = v; }
    else { const int col = 32 * slab + cin;
        o.x = pg8::cvt_pk_bf16(v.x, v.y); o.y = pg8::cvt_pk_bf16(v.z, v.w);
        *(v2u*)(P.KV + row * 256 + col) = o;
        *(f32x4*)(P.out + (col < 128 ? O_KS : O_VS) + (size_t)b * 16384 + 127 * 128 + (col & 127)) = v; }
    __syncthreads();
}

__device__ __forceinline__ void out_unit(LAS unsigned char* lds, int b, int c, const unsigned* UV, const bf16* ATT, const float* AGG, const bf16* WF, const bf16* x, const float* gpost, float* y, float* out, bool att_in_lds) {
    int tid = threadIdx.x; asm volatile("" : "+v"(tid));
    const int lane = tid & 63, w = __builtin_amdgcn_readfirstlane(tid >> 6), fr = lane & 15, fq = lane >> 4;
    const size_t row0 = (size_t)b * SEQ + 64 * c;
    typedef f16 f16x8 __attribute__((ext_vector_type(8)));
    f16x8 p0[8], p1[8];
#pragma unroll
    for (int i = 0; i < 8; ++i) { const int e = tid + 512 * i, r = e >> 6, cc = e & 63;
        p0[i] = *(const f16x8*)(UV + (row0 + r) * 512 + cc * 8); p1[i] = *(const f16x8*)(UV + (row0 + r) * 512 + cc * 8 + 4); }
    v4u pfo[8]; l2_warm_issue<8>(pfo, WF, tid);
    __builtin_amdgcn_sched_barrier(0);
    {
        const float* ag = AGG + (size_t)b * NCHUNK * 1024 + tid;
        const int q = c >> 3;
        float pa[8], pb[8];
#pragma unroll
        for (int k = 0; k < 8; ++k) { pa[k] = 1.f; pb[k] = 0.f; }
        float ta[7], tb[7];
#pragma unroll
        for (int jj = 0; jj < 7; ++jj) { const int j = (8 * q + jj < c) ? 8 * q + jj : (c > 0 ? c - 1 : 0); ta[jj] = ag[(size_t)j * 1024]; tb[jj] = ag[(size_t)j * 1024 + 512]; }
        const float ca = ag[(size_t)c * 1024], cb = ag[(size_t)c * 1024 + 512];
        __builtin_amdgcn_sched_barrier(0);
#pragma unroll 1
        for (int j0 = 0; j0 < q; j0 += 4) {
            float A[8][4], B[8][4];
#pragma unroll
            for (int k = 0; k < 8; ++k)
#pragma unroll
                for (int jj = 0; jj < 4; ++jj) { const int j = (j0 + jj < q) ? j0 + jj : q - 1; A[k][jj] = ag[(size_t)(k * q + j) * 1024]; B[k][jj] = ag[(size_t)(k * q + j) * 1024 + 512]; }
            __builtin_amdgcn_sched_barrier(0);
#pragma unroll
            for (int jj = 0; jj < 4; ++jj) if (j0 + jj < q) {
#pragma unroll
                for (int k = 0; k < 8; ++k) { pb[k] = A[k][jj] * pb[k] + B[k][jj]; pa[k] *= A[k][jj]; } }
            __builtin_amdgcn_sched_barrier(0);
        }
        float hin = pb[0];
#pragma unroll
        for (int k = 1; k < 8; ++k) hin = pa[k] * hin + pb[k];
#pragma unroll
        for (int jj = 0; jj < 7; ++jj) if (8 * q + jj < c) hin = ta[jj] * hin + tb[jj];
        ((LAS float*)(lds + A_HIN))[tid] = hin;
        l2_warm_retire<8>(pfo, (unsigned*)(out + O_RP));
        if (c == NCHUNK - 1) out[O_RP + b * 512 + tid] = ca * hin + cb;
    }
    VM_WAIT(); __syncthreads();
    {   v4u at[8];
#pragma unroll
        for (int i = 0; i < 8; ++i) { const int e = tid + 512 * i, r = e >> 6, cc = e & 63;
            at[i] = *(const v4u*)(ATT + (row0 + (att_in_lds ? 0 : r)) * 512 + cc * 8); }
        __builtin_amdgcn_sched_barrier(0);
        LDS_WAIT(); __syncthreads();
#pragma unroll
        for (int i = 0; i < 8; ++i) { const int e = tid + 512 * i, r = e >> 6, cc = e & 63;
            const f32x4 h0 = *(const LAS f32x4*)(lds + A_HIN + cc * 32), h1 = *(const LAS f32x4*)(lds + A_HIN + cc * 32 + 16);
            v4u o; o.x = pg8::cvt_pk_bf16((float)p0[i][0] + (float)p0[i][1] * h0.x, (float)p0[i][2] + (float)p0[i][3] * h0.y); o.y = pg8::cvt_pk_bf16((float)p0[i][4] + (float)p0[i][5] * h0.z, (float)p0[i][6] + (float)p0[i][7] * h0.w);
            o.z = pg8::cvt_pk_bf16((float)p1[i][0] + (float)p1[i][1] * h1.x, (float)p1[i][2] + (float)p1[i][3] * h1.y); o.w = pg8::cvt_pk_bf16((float)p1[i][4] + (float)p1[i][5] * h1.z, (float)p1[i][6] + (float)p1[i][7] * h1.w);
            *(LAS v4u*)(lds + A_RNN + r * A_STRIDE + cc * 16) = o; if (!att_in_lds) *(LAS v4u*)(lds + A_ATT + r * A_STRIDE + cc * 16) = at[i]; }
    }
    LDS_WAIT(); __syncthreads();
    f32x4 acc[4][8];
#pragma unroll
    for (int mt = 0; mt < 4; ++mt)
#pragma unroll
        for (int nt = 0; nt < 8; ++nt) acc[mt][nt] = (f32x4){0.f, 0.f, 0.f, 0.f};
    const bf16* wf = WF + (size_t)w * (32 * 8 * 64 * 8) + lane * 8;
    const LAS unsigned char* abase = lds + fr * A_STRIDE + fq * 16;
    bf16x8 b0[8], b1[8];
#define OU_LOADB(dst, ks) do { _Pragma("unroll") for (int nt = 0; nt < 8; ++nt) dst[nt] = *(const bf16x8*)(wf + (size_t)(((ks) * 8 + nt) * 512)); } while (0)
#define OU_STEP(bw, ks) do { bf16x8 af[4]; const LAS unsigned char* ap = abase + (((ks) < 16) ? A_RNN : A_ATT) + (((ks) & 15) * 64); \
        _Pragma("unroll") for (int mt = 0; mt < 4; ++mt) af[mt] = *(const LAS bf16x8*)(ap + mt * 16 * A_STRIDE); \
        _Pragma("unroll") for (int mt = 0; mt < 4; ++mt) _Pragma("unroll") for (int nt = 0; nt < 8; ++nt) acc[mt][nt] = __builtin_amdgcn_mfma_f32_16x16x32_bf16(bw[nt], af[mt], acc[mt][nt], 0, 0, 0); } while (0)
    OU_LOADB(b0, 0);
#pragma unroll 1
    for (int ks = 0; ks < 32; ks += 2) {
        OU_LOADB(b1, ks + 1); __builtin_amdgcn_sched_barrier(0);
        OU_STEP(b0, ks); __builtin_amdgcn_sched_barrier(0);
        OU_LOADB(b0, (ks + 2 < 32 ? ks + 2 : 31)); __builtin_amdgcn_sched_barrier(0);
        OU_STEP(b1, ks + 1); __builtin_amdgcn_sched_barrier(0);
    }
#undef OU_LOADB
#undef OU_STEP
    int tid2 = threadIdx.x; asm volatile("" : "+v"(tid2)); const int fr2 = tid2 & 15, fq2 = (tid2 >> 4) & 3;
    LAS float* part = (LAS float*)(lds + A_PART);
#pragma unroll
    for (int mt = 0; mt < 4; ++mt) { float ss = 0.f;
#pragma unroll
        for (int nt = 0; nt < 8; ++nt) { const f32x4 v = acc[mt][nt]; ss += (v.x * v.x + v.y * v.y) + (v.z * v.z + v.w * v.w); }
        ss += __shfl_xor(ss, 16); ss += __shfl_xor(ss, 32);
        if (fq2 == 0) part[w * 64 + 16 * mt + fr2] = ss; }
    LDS_WAIT(); __syncthreads();
    constexpr int YS = 4112;
    const int lane2 = tid2 & 63;
    f32x4 gv[4];
#pragma unroll
    for (int j = 0; j < 4; ++j) gv[j] = *(const f32x4*)(gpost + 4 * lane2 + 256 * j);
    v2u xv[2][2][4];
    const bf16* xb0 = x + (row0 + 2 * w) * DM + 4 * lane2;
#pragma unroll
    for (int rr = 0; rr < 2; ++rr)
#pragma unroll
        for (int j = 0; j < 4; ++j) xv[0][rr][j] = __builtin_nontemporal_load((const v2u*)(xb0 + (size_t)rr * DM + 256 * j));
    __builtin_amdgcn_sched_barrier(0);
#pragma unroll
    for (int mt = 0; mt < 4; ++mt) { float ss = 0.f;
        if (mt < 3) {
#pragma unroll
            for (int rr = 0; rr < 2; ++rr)
#pragma unroll
                for (int j = 0; j < 4; ++j) xv[(mt + 1) & 1][rr][j] = __builtin_nontemporal_load((const v2u*)(xb0 + (size_t)(16 * (mt + 1) + rr) * DM + 256 * j));
        }
        __builtin_amdgcn_sched_barrier(0);
#pragma unroll
        for (int ww = 0; ww < 8; ++ww) ss += part[ww * 64 + 16 * mt + fr2];
        const float rs = rsqrtf(ss * (1.0f / DM) + EPS);
#pragma unroll
        for (int nt = 0; nt < 8; ++nt) *(LAS f32x4*)(lds + fr2 * YS + (128 * w + 16 * nt + 4 * fq2) * 4) = acc[mt][nt] * rs;
        LDS_WAIT(); __syncthreads();
#pragma unroll
        for (int rr = 0; rr < 2; ++rr)
#pragma unroll
            for (int j = 0; j < 4; ++j) { const f32x4 v = *(const LAS f32x4*)(lds + (2 * w + rr) * YS + (4 * lane2 + 256 * j) * 4);
                const v2u xq = xv[mt & 1][rr][j]; const f32x4 xf = {__uint_as_float(xq.x << 16), __uint_as_float(xq.x & 0xffff0000u), __uint_as_float(xq.y << 16), __uint_as_float(xq.y & 0xffff0000u)};
                __builtin_nontemporal_store(xf + v * gv[j], (f32x4*)(y + (row0 + 16 * mt + 2 * w + rr) * DM + 4 * lane2 + 256 * j)); }
        LDS_WAIT(); __syncthreads(); }
}
typedef unsigned long long u64x2 __attribute__((ext_vector_type(2)));
__device__ __forceinline__ u64x2 ld16_sc1(const void* p) { const unsigned long long* q = (const unsigned long long*)p;
    u64x2 r; r.x = __hip_atomic_load(q, __ATOMIC_RELAXED, __HIP_MEMORY_SCOPE_AGENT); r.y = __hip_atomic_load(q + 1, __ATOMIC_RELAXED, __HIP_MEMORY_SCOPE_AGENT); return r; }
__device__ __forceinline__ void sample_out_unit(LAS unsigned char* lds, int su, const bf16* MIX, const bf16* WF, float* OUTS) {
    int tid = threadIdx.x; asm volatile("" : "+v"(tid));
    const int lane = tid & 63, w = __builtin_amdgcn_readfirstlane(tid >> 6), fr = lane & 15, fq = lane >> 4;
    const int rg = su >> 4, cg = su & 15;
    const bf16* bp = WF + ((size_t)((cg >> 1) * 32 * 8 + 4 * (cg & 1)) * 64 + lane) * 8;
    const bf16* ap = MIX + (size_t)(MP + 32 * rg + fr) * DM + 128 * w + 8 * fq;
    bf16x8 af[2][4], bw[4][4];
#pragma unroll
    for (int k = 0; k < 4; ++k) {
#pragma unroll
        for (int j = 0; j < 4; ++j) bw[j][k] = *(const bf16x8*)(bp + (size_t)(4 * w + k) * 8 * 512 + j * 512);
#pragma unroll
        for (int mt = 0; mt < 2; ++mt) af[mt][k] = *(const bf16x8*)(ap + (size_t)(16 * mt) * DM + 32 * k); }
    __builtin_amdgcn_sched_barrier(0);
    LAS float* red = (LAS float*)lds;
#pragma unroll
    for (int mt = 0; mt < 2; ++mt)
#pragma unroll
        for (int j = 0; j < 4; ++j) { f32x4 acc = {0.f, 0.f, 0.f, 0.f};
#pragma unroll
            for (int k = 0; k < 4; ++k) acc = __builtin_amdgcn_mfma_f32_16x16x32_bf16(bw[j][k], af[mt][k], acc, 0, 0, 0);
            *(LAS f32x4*)(red + ((w * 8 + mt * 4 + j) * 64 + lane) * 4) = acc; }
    LDS_WAIT(); __syncthreads();
    f32x4 v = {0.f, 0.f, 0.f, 0.f};
#pragma unroll
    for (int ww = 0; ww < 8; ++ww) v += *(const LAS f32x4*)(red + ((ww * 8 + w) * 64 + lane) * 4);
    { float* op = OUTS + (size_t)(32 * rg + 16 * (w >> 2) + fr) * DM + 128 * (cg >> 1) + 16 * (4 * (cg & 1) + (w & 3)) + 4 * fq;
      asm volatile("global_store_dwordx4 %0, %1, off sc0 sc1\n\ts_nop 1" :: "v"(op), "v"(v) : "memory"); }
    __syncthreads();
}

#ifndef MK_N_LAUNCHES
#define MK_N_LAUNCHES 1
#endif
constexpr int N_PHASES = 3;
struct Args { const float* in[19]; float* out; unsigned char* ws; int ph_lo, ph_hi; };
static_assert(sizeof(Args) == 19 * 8 + 8 + 8 + 8, "Args has no padding");

__global__ void __launch_bounds__(512, 2) mk_fwd(Args args) {
    extern __shared__ __attribute__((aligned(16))) unsigned char lds_raw[];
    LAS unsigned char* lds = (LAS unsigned char*)lds_raw;
    volatile LAS unsigned* MISC = (volatile LAS unsigned*)(lds + MISC_OFF);
    const int tid = threadIdx.x, lane = tid & 63, wave = __builtin_amdgcn_readfirstlane(tid >> 6);
    const int G = gridDim.x, bid = blockIdx.x;
    unsigned char* ws = args.ws; float* out = args.out;
    const float* x_prompt = args.in[0]; const float* x_sample = args.in[1]; const float* state_conv = args.in[2]; const float* state_rnn = args.in[3];
    const float* cache_k = args.in[4]; const float* cache_v = args.in[5]; const float* norm_pre = args.in[6]; const float* norm_post = args.in[7];
    const float* w_in = args.in[8]; const float* conv_w = args.in[9]; const float* conv_b = args.in[10]; const float* w_a = args.in[11]; const float* b_a = args.in[12];
    const float* w_x = args.in[13]; const float* b_x = args.in[14]; const float* lam = args.in[15]; const float* sinks = args.in[16]; const float* rel_bias = args.in[17];
    const float* w_out = args.in[18];
    bf16* WA = (bf16*)(ws + WS_WA); bf16* WB = (bf16*)(ws + WS_WB); bf16* WT_OUT = (bf16*)(ws + WS_WOUT); bf16* WG = (bf16*)(ws + WS_WG); bf16* WKV = (bf16*)(ws + WS_WKV); float* RSTD = (float*)(ws + WS_RSTD); float* AGG = (float*)(ws + WS_AGG);
    bf16* XB = (bf16*)(ws + WS_XB); bf16* XR = (bf16*)(ws + WS_XR); bf16* SGR = (bf16*)(ws + WS_SGR); bf16* Qb = (bf16*)(ws + WS_Q); bf16* SGA = (bf16*)(ws + WS_SGA);
    bf16* KV = (bf16*)(ws + WS_KV); bf16* MIX = (bf16*)(ws + WS_MIX); float* OUTS = (float*)(ws + WS_OUTS);
    unsigned* ctl = (unsigned*)(ws + WS_CTL);

    if (wave >= 4) __builtin_amdgcn_s_setprio(1);
    for (int u = tid; u < (LDS_BYTES - LDSCTL_OFF) / 4; u += 512) ((LAS unsigned*)(lds + LDSCTL_OFF))[u] = 0u;
    __syncthreads();
    XcdBarrier bar; bar.bar = ctl + CW_BAR; bar.x = 0; bar.st = nullptr;
    if (MK_N_LAUNCHES == 1) bar = xcd_barrier_post(ctl + CW_BAR, MISC + 8);
    const int lo = args.ph_lo, hi = args.ph_hi;
    SmpPre spre;
#pragma unroll
    for (int i = 0; i < 4; ++i) { spre.kk[i] = (f32x4){0.f, 0.f, 0.f, 0.f}; spre.vv[i] = (f32x4){0.f, 0.f, 0.f, 0.f}; }
#define IN(k) (lo <= (k) && (k) < hi)
#define BOTH(k) (IN(k) && IN((k) + 1))
#define GRID_BAR() do { if (MK_N_LAUNCHES == 1) xcd_barrier(bar); } while (0)

    if (IN(0)) {
        LAS float* scr = (LAS float*)(lds + wave * 16384);
        const int gw = wave * G + bid, NGW = G * 8;
        constexpr int I_IN = (DM / 64) * (DIN / 32), I_OUT = (DM / 64) * (DM / 32), I_G = 16 * 2;
        for (int it = gw; it < I_IN + I_OUT + I_G; it += NGW) {
            int r = it;
            if (r < I_IN) { const int n0 = 32 * (r % (DIN / 32));
                if (n0 < 1024) p0_transpose_item<3>(w_in, DM, DIN, WA, norm_pre, scr, r, lane, n0);
                else if (n0 < 1536) p0_transpose_item<3>(w_in, DM, DIN, WB, norm_pre, scr, r, lane, n0 - 1024);
                else if (n0 < 1792) p0_transpose_item<4>(w_in, DM, DIN, WKV, norm_pre, scr, r, lane, n0 - 1536);
                else p0_transpose_item<3>(w_in, DM, DIN, WB, norm_pre, scr, r, lane, n0 - 1792 + 512);
                continue; } r -= I_IN;
            if (r < I_OUT) { p0_transpose_item<1>(w_out, DM, DM, WT_OUT, nullptr, scr, r, lane, 32 * (r % (DM / 32))); continue; } r -= I_OUT;
            { const int mat = r >> 1, blk = mat >> 1, gate = mat & 1; p0_transpose_item<0>((gate ? w_x : w_a) + blk * 4096, 64, 64, WG + (size_t)mat * 4096, nullptr, scr, r & 1, lane, 32 * (r & 1), -LOG2E); }
        }
        for (int m0 = MP + (NGW - 1 - gw) * 8; m0 < MT; m0 += NGW * 8) {
            const float* xr[8]; bf16* orow[8]; float* rsp[8];
#pragma unroll
            for (int r = 0; r < 8; ++r) { const int m = m0 + r; xr[r] = x_sample + (size_t)(m - MP) * DM; orow[r] = XB + (size_t)m * DM; rsp[r] = RSTD + m; }
            p0_rows<8>(xr, orow, rsp, lane);
        }
        if (BOTH(0)) GRID_BAR();
    }
    if (IN(1)) {
        {
            ProjArgs PA{x_prompt, WA, WB, WKV, XR, SGR, Qb, SGA, KV, out, ctl + 960, (bf16*)(ws + WS_XB2)};
            SprojArgs SP{XB, WA, WB, WKV, RSTD, XR, SGR, Qb, KV, SGA, out};
            const int nsl = DIN / 16;
            const int sl_first = ((bid & 1) && (bid >> 1) < 128) ? (bid >> 1) : -1, sl_last = (!(bid & 1) && (bid >> 1) < nsl - 128 && G >= 256) ? 128 + (bid >> 1) : -1;
            if (G >= 256) { if (sl_first >= 0) sample_proj_unit(lds, sl_first, SP); }
            else for (int sl = bid; sl < nsl; sl += G) sample_proj_unit(lds, sl, SP);
            for (int u = bid; u < MP / 64; u += G) proj_unit(lds, u, PA);
            if (sl_last >= 0) sample_proj_unit(lds, sl_last, SP);
        }
        if (BOTH(1)) {
            LAS float* btab0 = (LAS float*)(lds + BTAB_OFF);
            for (int e = tid; e < 1024; e += 512) { const int h = e >> 7, d = e & 127; btab0[e] = rel_bias[t5_bucket(d) * NH + h] * LOG2E; }
            attn_table(lds, rel_bias);
            if (bid < 2 * DECB && !(G >= 256 && ((bid >> 1) & 1))) sample_prefetch(spre, cache_k, cache_v, bid >> 1, bid & 1, tid);
            GRID_BAR();
        }
    }
    if (IN(2)) {
        LAS float* btab = (LAS float*)(lds + BTAB_OFF);
        const bool pre_ok = BOTH(1);
        if (!pre_ok) { for (int e = tid; e < 1024; e += 512) { const int h = e >> 7, d = e & 127; btab[e] = rel_bias[t5_bucket(d) * NH + h] * LOG2E; } }
        __syncthreads();
        RgArgs R{XR, SGR, WG, conv_w, conv_b, b_a, b_x, lam, AGG, (unsigned*)XB};
        SmpArgs SA{XR, SGR, Qb, KV, SGA, WG, state_conv, state_rnn, cache_k, cache_v, conv_w, conv_b, b_a, b_x, lam, sinks, MIX, out};
        const bool r_first = G >= 256 && ((bid >> 1) & 1);
        if (!r_first) {
            if (pre_ok && bid < 2 * DECB) { sample_unit<true>(lds, btab, SA, bid >> 1, bid & 1, ctl + CW_SMP, spre);
                for (int u = bid + G; u < 2 * DECB; u += G) sample_unit<false>(lds, btab, SA, u >> 1, u & 1, ctl + CW_SMP, spre); }
            else for (int u = bid; u < 2 * DECB; u += G) sample_unit<false>(lds, btab, SA, u >> 1, u & 1, ctl + CW_SMP, spre);
        }
        for (int u = bid; u < BATCH * NCHUNK; u += G) { rglru_unit(lds, R, u / NCHUNK, u % NCHUNK);
            if (tid == 0) __hip_atomic_fetch_add(ctl + CW_AGG, 1u, __ATOMIC_RELAXED, __HIP_MEMORY_SCOPE_AGENT); }
        if (r_first) for (int u = bid; u < 2 * DECB; u += G) sample_unit<false>(lds, btab, SA, u >> 1, u & 1, ctl + CW_SMP, spre);
        {
            bool waited = false;
            const int sob = G >= 192 ? 128 : 0;
            for (int su = bid - sob; su >= 0 && su < 64; su += G) {
                if (!waited) {
                    if (tid == 0) { unsigned sp = 0; while (__hip_atomic_load(ctl + CW_SMP, __ATOMIC_RELAXED, __HIP_MEMORY_SCOPE_AGENT) < (unsigned)(2 * DECB)) { __builtin_amdgcn_s_sleep(2); if (++sp > (1u << 22)) break; }
                        __builtin_amdgcn_fence(__ATOMIC_ACQUIRE, "agent"); VM_WAIT(); }
                    __syncthreads(); waited = true; }
                sample_out_unit(lds, su, MIX, WT_OUT, OUTS);
                VM_WAIT(); __syncthreads();
                if (tid == 0) __hip_atomic_fetch_add(ctl + CW_OUTS, 1u, __ATOMIC_RELAXED, __HIP_MEMORY_SCOPE_AGENT);
            }
        }
        for (int u = bid; u < BATCH * NCHUNK; u += G) attn_unit(lds, u / NCHUNK, u % NCHUNK, Qb, KV, SGA, sinks, rel_bias, Qb, !(pre_ok && u == bid), BATCH * NCHUNK <= G);
        {
            if (tid == 0) { unsigned sp = 0; while (__hip_atomic_load(ctl + CW_AGG, __ATOMIC_RELAXED, __HIP_MEMORY_SCOPE_AGENT) < (unsigned)(BATCH * NCHUNK)) { __builtin_amdgcn_s_sleep(2); if (++sp > (1u << 22)) break; }
                __builtin_amdgcn_fence(__ATOMIC_ACQUIRE, "agent"); VM_WAIT(); }
            __syncthreads();
        }
        for (int u = bid; u < BATCH * NCHUNK; u += G) out_unit(lds, u / NCHUNK, u % NCHUNK, (const unsigned*)XB, Qb, AGG, WT_OUT, (const bf16*)(ws + WS_XB2), norm_post, out + O_YP, out, BATCH * NCHUNK <= G);
        if (bid < DECB) {
            if (tid == 0) { unsigned sp = 0; while (__hip_atomic_load(ctl + CW_OUTS, __ATOMIC_RELAXED, __HIP_MEMORY_SCOPE_AGENT) < 64u) { __builtin_amdgcn_s_sleep(2); if (++sp > (1u << 22)) break; } }
            __syncthreads();
            for (int b = bid; b < DECB; b += G) if (wave == 0) {
                const f32x4* r4 = (const f32x4*)(OUTS + (size_t)b * DM) + lane; const f32x4* x4 = (const f32x4*)(x_sample + (size_t)b * DM) + lane; f32x4* y4 = (f32x4*)(out + O_YS + (size_t)b * DM) + lane;
                f32x4 v[4]; float ss = 0.f;
#pragma unroll
                for (int j = 0; j < 4; ++j) { v[j] = __builtin_bit_cast(f32x4, ld16_sc1(r4 + 64 * j)); ss += (v[j].x * v[j].x + v[j].y * v[j].y) + (v[j].z * v[j].z + v[j].w * v[j].w); }
                const float rs = rsqrtf(wave_sum(ss) * (1.0f / DM) + EPS);
#pragma unroll
                for (int j = 0; j < 4; ++j) { const f32x4 gg = ((const f32x4*)norm_post)[lane + 64 * j]; y4[64 * j] = x4[64 * j] + v[j] * rs * gg; }
            }
        }
    }
#undef IN
#undef BOTH
#undef GRID_BAR
}

extern "C" void kernel_launch(void* const* d_in, const int* in_sizes, int n_in, void* d_out, int out_size, void* d_ws, size_t ws_size, hipStream_t stream) {
    static int grid = 0;
    if (grid == 0) {
        int dev = 0, cus = 0;
        if (hipGetDevice(&dev) != hipSuccess || hipDeviceGetAttribute(&cus, hipDeviceAttributeMultiprocessorCount, dev) != hipSuccess) { fprintf(stderr, "kernel_launch: device query failed\n"); grid = -1; return; }
        if (hipFuncSetAttribute((const void*)mk_fwd, hipFuncAttributeMaxDynamicSharedMemorySize, LDS_BYTES) != hipSuccess) { fprintf(stderr, "kernel_launch: hipFuncSetAttribute failed\n"); grid = -1; return; }
        int per_cu = 0;
        if (hipOccupancyMaxActiveBlocksPerMultiprocessor(&per_cu, (const void*)mk_fwd, 512, LDS_BYTES) != hipSuccess || per_cu < 1) { fprintf(stderr, "kernel_launch: occupancy query says %d blocks/CU\n", per_cu); }
        (void)hipGetLastError();
        grid = cus;
    }
    if (grid < 0) return;
    (void)hipMemsetAsync((char*)d_ws + WS_CTL, 0, CTL_ZERO_BYTES, stream);
    Args a{};
    for (int i = 0; i < 19; ++i) a.in[i] = (const float*)d_in[i];
    a.out = (float*)d_out; a.ws = (unsigned char*)d_ws;
    if (MK_N_LAUNCHES == 1) { a.ph_lo = 0; a.ph_hi = N_PHASES; hipLaunchKernelGGL(mk_fwd, dim3(grid), dim3(512), LDS_BYTES, stream, a); }
    else for (int p = 0; p < N_PHASES; ++p) { a.ph_lo = p; a.ph_hi = p + 1; hipLaunchKernelGGL(mk_fwd, dim3(grid), dim3(512), LDS_BYTES, stream, a); }
}
```

```cpp
#include <hip/hip_runtime.h>
#include <cstdint>
#include <cstdio>

namespace pg8 {
__device__ __forceinline__ unsigned cvt_pk_bf16(float lo, float hi) { unsigned r; asm volatile("v_cvt_pk_bf16_f32 %0, %1, %2" : "=v"(r) : "v"(lo), "v"(hi)); return r; }
}

typedef unsigned short bf16;
#define LAS __attribute__((address_space(3)))
#define GAS __attribute__((address_space(1)))
typedef unsigned v4u __attribute__((ext_vector_type(4)));
typedef unsigned v2u __attribute__((ext_vector_type(2)));
typedef float f32x4 __attribute__((ext_vector_type(4)));
typedef short bf16x8 __attribute__((ext_vector_type(8)));
constexpr int DM = 1024, BATCH = 2, SEQ = 8192, DECB = 128;
constexpr int DRNN = 512, DATT = 512, NH = 8, HD = 64, NKV = 2, KVD = 128, WIN = 128, NBUCK = 32;
constexpr int DIN = 2304;
constexpr int MP = BATCH * SEQ;
constexpr int MT = MP + DECB;
constexpr int MPAD = 16640;
constexpr int NCHUNK = SEQ / 64;
constexpr float EPS = 1e-6f;
constexpr float LOG2E = 1.4426950408889634f;
constexpr float QSCALE = 0.125f * LOG2E;

constexpr size_t O_YP = 0, O_YS = O_YP + (size_t)MP * DM, O_CP = O_YS + (size_t)DECB * DM, O_RP = O_CP + 2 * 3 * 512, O_KP = O_RP + 2 * 512,
                 O_VP = O_KP + 2 * 128 * 128, O_CS = O_VP + 2 * 128 * 128, O_RS = O_CS + (size_t)DECB * 3 * 512, O_KS = O_RS + (size_t)DECB * 512,
                 O_VS = O_KS + (size_t)DECB * 128 * 128, O_END = O_VS + (size_t)DECB * 128 * 128;

constexpr size_t MiB = 1u << 20;
constexpr size_t WS_CTL = 0, CTL_ZERO_BYTES = 32768;
constexpr size_t WS_WA = 1 * MiB;
constexpr size_t WS_WB = 3 * MiB;
constexpr size_t WS_WOUT = 6 * MiB;
constexpr size_t WS_WG = 8 * MiB;
constexpr size_t WS_WKV = 8 * MiB + 128 * 1024;
constexpr size_t WS_RSTD = 8 * MiB + 768 * 1024;
constexpr size_t WS_AGG = 9 * MiB;
constexpr size_t WS_XB = 10 * MiB;
constexpr size_t WS_XR = 43 * MiB;
constexpr size_t WS_SGR = 60 * MiB;
constexpr size_t WS_Q = 77 * MiB;
constexpr size_t WS_SGA = 94 * MiB;
constexpr size_t WS_KV = 111 * MiB;
constexpr size_t WS_MIX = 120 * MiB;
constexpr size_t WS_OUTS = 153 * MiB;
constexpr size_t WS_XB2 = 154 * MiB;
constexpr size_t WS_GA = 186 * MiB;
constexpr size_t WS_END = 187 * MiB;
constexpr int CW_SMP = 512;
constexpr int CW_AGG = 576;
constexpr int CW_OUTS = 640;
constexpr int CW_GA = 704;
constexpr int CW_BAR = 1024;

constexpr int RING_BYTES = 131072, LDSCTL_OFF = 153600, MISC_OFF = LDSCTL_OFF + 320, LDS_BYTES = 155648;
constexpr int A_STRIDE = 1040;
constexpr int A_ATT = 0, A_RNN = 66560, A_PART = 133120, A_HIN = 135168;
static_assert(A_RNN + 64 * A_STRIDE <= A_PART && A_HIN + 2048 <= LDSCTL_OFF, "lds map");

#define LDS_WAIT() asm volatile("s_waitcnt lgkmcnt(0)" ::: "memory")
#define ST_WT128(ptr, val) asm volatile("global_store_dwordx4 %0, %1, off sc0 sc1\n\ts_nop 1" :: "v"(ptr), "v"(val) : "memory")
#define VM_WAIT() asm volatile("s_waitcnt vmcnt(0)" ::: "memory")
__device__ __forceinline__ float bf2f(bf16 v) { return __uint_as_float((unsigned)v << 16); }
__device__ __forceinline__ unsigned f2bf(float f) { unsigned u = __float_as_uint(f); return (u + 0x7fffu + ((u >> 16) & 1u)) >> 16; }
__device__ __forceinline__ unsigned pk2(float lo, float hi) { return f2bf(lo) | (f2bf(hi) << 16); }
__device__ __forceinline__ float ex2(float x) { return __builtin_amdgcn_exp2f(x); }
__device__ __forceinline__ float rcpf_(float x) { return __builtin_amdgcn_rcpf(x); }
__device__ __forceinline__ float sigmoid_(float x) { return rcpf_(1.0f + ex2(-LOG2E * x)); }
__device__ __forceinline__ float silu_(float x) { return x * sigmoid_(x); }
__device__ __forceinline__ int t5_bucket(int dist) {
    if (dist < 0) dist = 0;
    if (dist < 16) return dist;
    const float d = (float)dist;
    int large = 16 + (int)(logf(d / 16.0f) / 2.0794415416798357f * 16.0f);
    return large < 31 ? large : 31;
}
__device__ __forceinline__ float softplus_neg(float l) { return (l > 0.f) ? log1pf(__expf(-l)) : (-l + log1pf(__expf(l))); }
__device__ __forceinline__ float wave_sum(float v) {
#pragma unroll
    for (int o = 1; o < 64; o <<= 1) v += __shfl_xor(v, o);
    return v;
}


#define XB_TMO      128
#define XB_XCNT(j)  (256  + 64 * (j))
#define XB_XSUB(j)  (1280 + 64 * (j))
#define XB_XGEN(j)  (2304 + 64 * (j))
#define XB_TOP      3328
#define XB_TOPGEN   3392
#define XCD_BAR_WORDS 3456
#define XB_SPIN_CAP (1u << 18)
__device__ __forceinline__ float ldf_sc1(const float* p) { return __hip_atomic_load(p, __ATOMIC_RELAXED, __HIP_MEMORY_SCOPE_AGENT); }
__device__ __forceinline__ unsigned xb_ld(unsigned* p)              { return __hip_atomic_load(p, __ATOMIC_RELAXED, __HIP_MEMORY_SCOPE_AGENT); }
__device__ __forceinline__ unsigned xb_add(unsigned* p, unsigned v) { return __hip_atomic_fetch_add(p, v, __ATOMIC_RELAXED, __HIP_MEMORY_SCOPE_AGENT); }
__device__ __forceinline__ unsigned xb_xcc_id() { return (unsigned)__builtin_amdgcn_s_getreg((3 << 11) | 20) & 0xFu; }
#define XB_SPIN(cond, bar) do { unsigned _sp = 0; while (cond) { __builtin_amdgcn_s_sleep(1); \
    if ((++_sp & 255u) == 0u) { if (xb_ld(&(bar)[XB_TMO])) break; if (_sp > XB_SPIN_CAP) { atomicAdd(&(bar)[XB_TMO], 1u); break; } } } } while (0)
struct XcdBarrier { unsigned* bar; unsigned x; volatile LAS unsigned* st; };
__device__ __forceinline__ XcdBarrier xcd_barrier_post(unsigned* bar, volatile LAS unsigned* st) {
    XcdBarrier b; b.bar = bar; b.x = xb_xcc_id(); b.st = st;
    if (threadIdx.x == 0) (void)xb_add(&bar[XB_XCNT(b.x)], 1u);
    return b;
}
__device__ __forceinline__ void xcd_barrier_complete(unsigned* bar, unsigned x, unsigned& nloc, unsigned& nx) {
    const unsigned G = gridDim.x * gridDim.y * gridDim.z;
    unsigned sum, cnt, mine, sp = 0u;
    for (;;) {
        sum = 0u; cnt = 0u; mine = 0u;
#pragma unroll
        for (unsigned j = 0; j < 16; ++j) { const unsigned c = xb_ld(&bar[XB_XCNT(j)]); sum += c; cnt += (c > 0u) ? 1u : 0u; mine = (j == x) ? c : mine; }
        if (sum == G) break;
        __builtin_amdgcn_s_sleep(1);
        if ((++sp & 255u) == 0u) { if (xb_ld(&bar[XB_TMO])) break; if (sp > XB_SPIN_CAP) { atomicAdd(&bar[XB_TMO], 1u); break; } }
    }
    nloc = mine > 0u ? mine : 1u; nx = cnt > 0u ? cnt : 1u;
}
__device__ __forceinline__ void xcd_barrier(const XcdBarrier& b) {
    asm volatile("s_waitcnt vmcnt(0)" ::: "memory");
    __syncthreads();
    if (threadIdx.x == 0) {
        unsigned* bar = b.bar;
        __builtin_amdgcn_s_waitcnt(0);
        unsigned nloc = b.st[0], nx = b.st[1];
        if (nloc == 0u) { xcd_barrier_complete(bar, b.x, nloc, nx); b.st[0] = nloc; b.st[1] = nx; }
        const unsigned old = xb_add(&bar[XB_XSUB(b.x)], 1u);
        const unsigned gen = old / nloc;
        if (old + 1u == (gen + 1u) * nloc) {
            __builtin_amdgcn_fence(__ATOMIC_RELEASE, "agent");
            asm volatile("s_waitcnt vmcnt(0)" ::: "memory");
            const unsigned og = xb_add(&bar[XB_TOP], 1u);
            const unsigned tg = og / nx;
            if (og + 1u == (tg + 1u) * nx) xb_add(&bar[XB_TOPGEN], 1u);
            else XB_SPIN(xb_ld(&bar[XB_TOPGEN]) == tg, bar);
            __builtin_amdgcn_fence(__ATOMIC_ACQUIRE, "agent");
            xb_add(&bar[XB_XGEN(b.x)], 1u);
            asm volatile("s_waitcnt vmcnt(0)" ::: "memory");
        } else {
            __builtin_amdgcn_fence(__ATOMIC_ACQUIRE, "agent");
            asm volatile("s_waitcnt vmcnt(0)" ::: "memory");
            XB_SPIN(xb_ld(&bar[XB_XGEN(b.x)]) == gen, bar);
        }
    }
    __syncthreads();
}

struct XbTicket { unsigned gen, tg, role; };
__device__ __forceinline__ XbTicket xcd_barrier_arrive(const XcdBarrier& b) {
    unsigned* bar = b.bar; XbTicket t; t.tg = 0u; t.role = 0u;
    __builtin_amdgcn_s_waitcnt(0);
    unsigned nloc = b.st[0], nx = b.st[1];
    if (nloc == 0u) { xcd_barrier_complete(bar, b.x, nloc, nx); b.st[0] = nloc; b.st[1] = nx; }
    const unsigned old = xb_add(&bar[XB_XSUB(b.x)], 1u);
    t.gen = old / nloc;
    if (old + 1u == (t.gen + 1u) * nloc) {
        __builtin_amdgcn_fence(__ATOMIC_RELEASE, "agent");
        asm volatile("s_waitcnt vmcnt(0)" ::: "memory");
        const unsigned og = xb_add(&bar[XB_TOP], 1u);
        t.tg = og / nx;
        if (og + 1u == (t.tg + 1u) * nx) { xb_add(&bar[XB_TOPGEN], 1u); t.role = 2u; } else t.role = 1u;
    }
    return t;
}
__device__ __forceinline__ void xcd_barrier_wait(const XcdBarrier& b, const XbTicket& t) {
    unsigned* bar = b.bar;
    if (t.role != 0u) {
        if (t.role == 1u) XB_SPIN(xb_ld(&bar[XB_TOPGEN]) == t.tg, bar);
        __builtin_amdgcn_fence(__ATOMIC_ACQUIRE, "agent");
        xb_add(&bar[XB_XGEN(b.x)], 1u);
        asm volatile("s_waitcnt vmcnt(0)" ::: "memory");
    } else {
        __builtin_amdgcn_fence(__ATOMIC_ACQUIRE, "agent");
        asm volatile("s_waitcnt vmcnt(0)" ::: "memory");
        XB_SPIN(xb_ld(&bar[XB_XGEN(b.x)]) == t.gen, bar);
    }
}

template <int MODE>
__device__ __forceinline__ void p0_transpose_item(const float* W, int K, int N, bf16* WT, const float* kscale, LAS float* scr, int item, int lane, int dst_n0, float gscale = 1.0f) {
    const int nblk = N / 32, kb = item / nblk, nb = item % nblk, k0 = 64 * kb, n0 = 32 * nb;
    {   float wv[32], sv[32];
#pragma unroll
        for (int i = 0; i < 32; ++i) { const int kk = 2 * i + (lane >> 5); wv[i] = __builtin_nontemporal_load(W + (size_t)(k0 + kk) * N + n0 + (lane & 31)); sv[i] = kscale ? kscale[k0 + kk] : 1.0f; }
        __builtin_amdgcn_sched_barrier(0);
#pragma unroll
        for (int i = 0; i < 32; ++i) { const int kk = 2 * i + (lane >> 5); scr[kk * 33 + (lane & 31)] = wv[i] * sv[i] * gscale; }
    }
    LDS_WAIT(); asm volatile("" ::: "memory");
    const int c = lane & 7;
#pragma unroll
    for (int j = 0; j < 4; ++j) { const int n = (lane >> 3) + 8 * j; const LAS float* sp = scr + (8 * c) * 33 + n;
        v4u o; o.x = pk2(sp[0 * 33], sp[1 * 33]); o.y = pk2(sp[2 * 33], sp[3 * 33]); o.z = pk2(sp[4 * 33], sp[5 * 33]); o.w = pk2(sp[6 * 33], sp[7 * 33]);
        const int nn = dst_n0 + n, kk = k0 + 8 * c;
        if (MODE == 3 || MODE == 4) {
            const int NTT = MODE == 3 ? 8 : 2, slab = MODE == 3 ? nn >> 7 : nn >> 5, cw = MODE == 3 ? nn & 127 : nn & 31, rem = cw & 31;
            const int nt = 2 * (cw >> 5) + ((rem >> 2) & 1), ln = 4 * (rem >> 3) + (rem & 3);
            { bf16* wp_ = WT + ((size_t)(((slab * 32 + (kk >> 5)) * NTT + nt) * 64 + (((kk >> 3) & 3) * 16 + ln))) * 8; ST_WT128(wp_, o); } }
        else if (MODE == 1) { bf16* wp_ = WT + ((size_t)((((nn >> 7) * 32 + (kk >> 5)) * 8 + ((nn >> 4) & 7)) * 64 + (((kk >> 3) & 3) * 16 + (nn & 15)))) * 8; ST_WT128(wp_, o); }
        else if (MODE == 2) *(v4u*)(WT + ((size_t)((((nn >> 5) * 32 + (kk >> 5)) * 2 + ((nn >> 4) & 1)) * 64 + (((kk >> 3) & 3) * 16 + (nn & 15)))) * 8) = o;
        else { bf16* wp_ = WT + (size_t)nn * K + kk; ST_WT128(wp_, o); } }
    LDS_WAIT(); asm volatile("" ::: "memory");
}
template <int NR>
__device__ __forceinline__ void p0_rows(const float* const (&xrow)[NR], bf16* const (&orow)[NR], float* const (&rs)[NR], int lane) {
    f32x4 v[NR][4];
#pragma unroll
    for (int r = 0; r < NR; ++r)
#pragma unroll
        for (int j = 0; j < 4; ++j) v[r][j] = ((const f32x4*)xrow[r])[lane + 64 * j];
    __builtin_amdgcn_sched_barrier(0);
#pragma unroll
    for (int r = 0; r < NR; ++r) { float s = 0.f;
#pragma unroll
        for (int j = 0; j < 4; ++j) s += (v[r][j].x * v[r][j].x + v[r][j].y * v[r][j].y) + (v[r][j].z * v[r][j].z + v[r][j].w * v[r][j].w);
        s = wave_sum(s);
        if (lane == 0) __hip_atomic_store(rs[r], rsqrtf(s * (1.0f / DM) + EPS), __ATOMIC_RELAXED, __HIP_MEMORY_SCOPE_AGENT);
        unsigned long long* o8 = (unsigned long long*)orow[r] + lane;
#pragma unroll
        for (int j = 0; j < 4; ++j) __hip_atomic_store(o8 + 64 * j, (unsigned long long)pk2(v[r][j].x, v[r][j].y) | ((unsigned long long)pk2(v[r][j].z, v[r][j].w) << 32), __ATOMIC_RELAXED, __HIP_MEMORY_SCOPE_AGENT); }
}

typedef _Float16 f16;
struct RgArgs { const bf16* XR; const bf16* SGR; const bf16* WG; const float* conv_w; const float* conv_b; const float* b_a; const float* b_x; const float* lam; float* AGG; unsigned* UV; };
constexpr int XCB_STRIDE = 1040;
constexpr int ZS = 516;
constexpr int RG_XCB = 0, RG_ZR = 16 * XCB_STRIDE, RG_ZI = RG_ZR + 16 * ZS * 4, RG_LDS = RG_ZI + 16 * ZS * 4;
static_assert(RG_LDS <= 100 * 1024, "rg lds");
__device__ __forceinline__ void rglru_unit(LAS unsigned char* lds, const RgArgs& R, int b, int c) {
    int tid = threadIdx.x; asm volatile("" : "+v"(tid));
    const int ch = tid, lane = tid & 63, w = __builtin_amdgcn_readfirstlane(tid >> 6);
    const size_t row0 = (size_t)b * SEQ + 64 * c;
    bf16x8 bw[2][4][2];
#pragma unroll
    for (int g = 0; g < 2; ++g)
#pragma unroll
        for (int nt = 0; nt < 4; ++nt)
#pragma unroll
            for (int ks = 0; ks < 2; ++ks) bw[g][nt][ks] = *(const bf16x8*)(R.WG + ((size_t)((w * 2 + g) * 64 + nt * 16 + (lane & 15))) * 64 + ks * 32 + 8 * (lane >> 4));
    const float cb = R.conv_b[ch], w0 = R.conv_w[ch], w1 = R.conv_w[512 + ch], w2 = R.conv_w[1024 + ch], w3 = R.conv_w[1536 + ch];
    const float ba = -LOG2E * R.b_a[ch], bxb = -LOG2E * R.b_x[ch];
    const float c2 = -8.0f * softplus_neg(R.lam[ch]) * LOG2E;
    float h = 0.f, acum = 1.0f;
    const bf16* xp = R.XR + row0 * 512 + ch;
    float xm3 = 0.f, xm2 = 0.f, xm1 = 0.f;
    if (c > 0) { xm3 = bf2f(xp[-3 * 512]); xm2 = bf2f(xp[-2 * 512]); xm1 = bf2f(xp[-1 * 512]); }
    unsigned xs[16], sg[16];
    const bf16* sp = R.SGR + row0 * 512 + ch;
#pragma unroll
    for (int i = 0; i < 16; ++i) { xs[i] = xp[i * 512]; sg[i] = sp[i * 512]; }
    __builtin_amdgcn_sched_barrier(0);
    LAS unsigned char* xcb = lds + RG_XCB; LAS float* zr = (LAS float*)(lds + RG_ZR); LAS float* zi = (LAS float*)(lds + RG_ZI);
    unsigned* uvp = R.UV + row0 * 512 + ch;
#pragma unroll 1
    for (int s = 0; s < 4; ++s) {
        unsigned xn[16], sn[16];
        { const int s1 = s < 3 ? s + 1 : 3;
#pragma unroll
            for (int i = 0; i < 16; ++i) { xn[i] = xp[(16 * s1 + i) * 512]; sn[i] = sp[(16 * s1 + i) * 512]; } }
        float xc[16];
#pragma unroll
        for (int i = 0; i < 16; ++i) { const float x = __uint_as_float(xs[i] << 16); xc[i] = cb + w0 * xm3 + w1 * xm2 + w2 * xm1 + w3 * x; xm3 = xm2; xm2 = xm1; xm1 = x;
            *(LAS bf16*)(xcb + i * XCB_STRIDE + ch * 2) = (bf16)pg8::cvt_pk_bf16(xc[i], 0.f); }
        LDS_WAIT(); __builtin_amdgcn_wave_barrier();
        {
            bf16x8 af[2];
#pragma unroll
            for (int ks = 0; ks < 2; ++ks) af[ks] = *(const LAS bf16x8*)(xcb + (lane & 15) * XCB_STRIDE + (64 * w + 32 * ks + 8 * (lane >> 4)) * 2);
#pragma unroll
            for (int g = 0; g < 2; ++g)
#pragma unroll
                for (int nt = 0; nt < 4; ++nt) { f32x4 acc = {0.f, 0.f, 0.f, 0.f};
#pragma unroll
                    for (int ks = 0; ks < 2; ++ks) acc = __builtin_amdgcn_mfma_f32_16x16x32_bf16(af[ks], bw[g][nt][ks], acc, 0, 0, 0);
                    LAS float* z = g ? zi : zr;
#pragma unroll
                    for (int r = 0; r < 4; ++r) z[(4 * (lane >> 4) + r) * ZS + 64 * w + 16 * nt + (lane & 15)] = acc[r]; }
        }
        LDS_WAIT(); __builtin_amdgcn_wave_barrier();
        typedef float f32x2 __attribute__((ext_vector_type(2)));
#pragma unroll
        for (int i = 0; i < 16; i += 2) {
            const f32x2 zrv = {zr[i * ZS + ch], zr[(i + 1) * ZS + ch]}, ziv = {zi[i * ZS + ch], zi[(i + 1) * ZS + ch]};
            const f32x2 er = zrv + ba, ei = ziv + bxb;
            f32x2 dr = {ex2(er.x), ex2(er.y)}, di = {ex2(ei.x), ex2(ei.y)};
            dr = dr + 1.0f; di = di + 1.0f;
            const f32x2 r = {rcpf_(dr.x), rcpf_(dr.y)}, ig = {rcpf_(di.x), rcpf_(di.y)};
            const f32x2 l2 = r * c2;
            const f32x2 a = {ex2(l2.x), ex2(l2.y)};
            const f32x2 x2 = l2 * 1.3862943611198906f;
            const f32x2 em_small = -x2 * ((x2 * 0.16666667f + 0.5f) * x2 + 1.0f);
            const f32x2 em_big = 1.0f - a * a;
            const f32x2 em = {(x2.x > -0.015625f) ? em_small.x : em_big.x, (x2.y > -0.015625f) ? em_small.y : em_big.y};
            const f32x2 sq = {__builtin_amdgcn_sqrtf(em.x), __builtin_amdgcn_sqrtf(em.y)};
            const f32x2 xcv = {xc[i], xc[i + 1]};
            const f32x2 bx = sq * (ig * xcv);
            const float h0 = __builtin_fmaf(a.x, h, bx.x), h1 = __builtin_fmaf(a.y, h0, bx.y);
            const float ac0 = acum * a.x, ac1 = ac0 * a.y;
            h = h1; acum = ac1;
            const f32x2 sgv = {__uint_as_float(sg[i] << 16), __uint_as_float(sg[i + 1] << 16)};
            const f32x2 uu = sgv * (f32x2){h0, h1}, vv2 = sgv * (f32x2){ac0, ac1};
            typedef f16 f16x2 __attribute__((ext_vector_type(2)));
            const f16x2 p0 = {(f16)uu.x, (f16)vv2.x}, p1 = {(f16)uu.y, (f16)vv2.y};
            __hip_atomic_store(uvp + (size_t)(16 * s + i) * 512, __builtin_bit_cast(unsigned, p0), __ATOMIC_RELAXED, __HIP_MEMORY_SCOPE_AGENT);
            __hip_atomic_store(uvp + (size_t)(16 * s + i + 1) * 512, __builtin_bit_cast(unsigned, p1), __ATOMIC_RELAXED, __HIP_MEMORY_SCOPE_AGENT);
        }
#pragma unroll
        for (int i = 0; i < 16; ++i) { xs[i] = xn[i]; sg[i] = sn[i]; }
    }
    { float* ag = R.AGG + ((size_t)b * NCHUNK + c) * 1024 + ch;
      __hip_atomic_store(ag, acum, __ATOMIC_RELAXED, __HIP_MEMORY_SCOPE_AGENT); __hip_atomic_store(ag + 512, h, __ATOMIC_RELAXED, __HIP_MEMORY_SCOPE_AGENT); }
    VM_WAIT(); __syncthreads();
}

typedef float f32x16 __attribute__((ext_vector_type(16)));
constexpr int AT_K = 0, AT_KS = 144, AT_NK = 192, AT_VT = 2 * AT_NK * AT_KS, AT_VS = 392, AT_T = AT_VT + 2 * 64 * AT_VS, AT_LDS = AT_T + 8 * 384 * 4;
static_assert(AT_LDS <= 144384, "attention lds");
__device__ __forceinline__ unsigned cvtpk(float lo, float hi) { unsigned r; asm volatile("v_cvt_pk_bf16_f32 %0, %1, %2" : "=v"(r) : "v"(lo), "v"(hi)); return r; }
__device__ __forceinline__ void attn_table(LAS unsigned char* lds, const float* rel_bias) {
    LAS float* T = (LAS float*)(lds + AT_T);
    for (int e = threadIdx.x; e < 8 * 384; e += 512) { const int hl = e / 384, ti = e - hl * 384; float v = -1e30f; if (ti >= 128 && ti <= 255) v = rel_bias[t5_bucket(255 - ti) * NH + hl] * LOG2E; T[e] = v; }
}
__device__ __forceinline__ void attn_unit(LAS unsigned char* lds, int b, int c, const bf16* Q, const bf16* KV, const bf16* SGA, const float* sinks, const float* rel_bias, bf16* MIX, bool build_T, bool to_lds) {
    int tid = threadIdx.x; asm volatile("" : "+v"(tid));
    const int lane = tid & 63, w = __builtin_amdgcn_readfirstlane(tid >> 6), r32 = lane & 31, hi = lane >> 5;
    const int n = c >> 1, half = c & 1, kt0 = 2 * half, h = w, g = w >> 2;
    const size_t rowblk = (size_t)b * SEQ + 128 * n;
    LAS float* T = (LAS float*)(lds + AT_T);
    {   v4u kk[6], vv[6];
#pragma unroll
        for (int i = 0; i < 6; ++i) { const int e = tid + 512 * i, key = e >> 4, gq = (e >> 3) & 1, cc = e & 7;
            const int kb = 32 * kt0 + key;
            const int ksrc = (n > 0 || kb >= 128) ? kb : kb + 128;
            const bf16* kr = KV + (rowblk - 128 + ksrc) * 256 + gq * 64 + cc * 8;
            kk[i] = *(const v4u*)kr; vv[i] = *(const v4u*)(kr + 128); }
        __builtin_amdgcn_sched_barrier(0);
#pragma unroll
        for (int i = 0; i < 6; ++i) { const int e = tid + 512 * i, key = e >> 4, gq = (e >> 3) & 1, cc = e & 7;
            *(LAS v4u*)(lds + AT_K + (gq * AT_NK + key) * AT_KS + cc * 16) = kk[i];
#pragma unroll
            for (int j = 0; j < 8; ++j) *(LAS bf16*)(lds + AT_VT + (gq * 64 + cc * 8 + j) * AT_VS + key * 2) = (bf16)((vv[i][j >> 1] >> (16 * (j & 1))) & 0xffffu); }
    }
    if (build_T) attn_table(lds, rel_bias);
    LDS_WAIT(); __syncthreads();
    const float sinkv = sinks[h] * LOG2E;
    v2u ovs[2][4];
#pragma unroll 1
    for (int i = 0; i < 2; ++i) {
        const int qt = kt0 + i; const size_t qrow = rowblk + 32 * qt + r32;
        bf16x8 qf[4];
#pragma unroll
        for (int ks = 0; ks < 4; ++ks) qf[ks] = *(const bf16x8*)(Q + qrow * 512 + h * 64 + 16 * ks + 8 * hi);
        v2u sgv[2][4];
#pragma unroll
        for (int dt = 0; dt < 2; ++dt)
#pragma unroll
            for (int i4 = 0; i4 < 4; ++i4) sgv[dt][i4] = *(const v2u*)(SGA + qrow * 512 + h * 64 + 32 * dt + 8 * i4 + 4 * hi);
        f32x16 s[5];
#pragma unroll
        for (int j = 0; j < 5; ++j) {
            const int kt = qt + j, ktl = i + j;
            if (n == 0 && kt < 4) {
#pragma unroll
                for (int r = 0; r < 16; ++r) s[j][r] = -1e30f;
            } else {
                const LAS float* tp = T + h * 384 + (32 * kt + 4 * hi - 32 * qt - r32 + 127);
#pragma unroll
                for (int r = 0; r < 16; ++r) s[j][r] = tp[(r & 3) + 8 * (r >> 2)];
                const LAS unsigned char* kp = lds + AT_K + (g * AT_NK + 32 * ktl + r32) * AT_KS + 16 * hi;
#pragma unroll
                for (int ks = 0; ks < 4; ++ks) { const bf16x8 kf = *(const LAS bf16x8*)(kp + 32 * ks); s[j] = __builtin_amdgcn_mfma_f32_32x32x16_bf16(kf, qf[ks], s[j], 0, 0, 0); }
            }
        }
        float m = sinkv;
#pragma unroll
        for (int j = 0; j < 5; ++j)
#pragma unroll
            for (int r = 0; r < 16; ++r) m = fmaxf(m, s[j][r]);
        { auto rr = __builtin_amdgcn_permlane32_swap(__float_as_uint(m), __float_as_uint(m), false, false); m = fmaxf(__uint_as_float(rr[0]), __uint_as_float(rr[1])); }
        float l = 0.f;
#pragma unroll
        for (int j = 0; j < 5; ++j)
#pragma unroll
            for (int r = 0; r < 16; ++r) { const float p = ex2(s[j][r] - m); s[j][r] = p; l += p; }
        { auto rr = __builtin_amdgcn_permlane32_swap(__float_as_uint(l), __float_as_uint(l), false, false); l = __uint_as_float(rr[0]) + __uint_as_float(rr[1]); }
        l += ex2(sinkv - m);
        f32x16 o[2];
#pragma unroll
        for (int r = 0; r < 16; ++r) { o[0][r] = 0.f; o[1][r] = 0.f; }
#pragma unroll
        for (int j = 0; j < 5; ++j) {
            const int kt = qt + j, ktl = i + j;
            if (!(n == 0 && kt < 4)) {
#pragma unroll
                for (int s2 = 0; s2 < 2; ++s2) {
                    v4u pw; pw.x = cvtpk(s[j][8 * s2 + 0], s[j][8 * s2 + 1]); pw.y = cvtpk(s[j][8 * s2 + 2], s[j][8 * s2 + 3]); pw.z = cvtpk(s[j][8 * s2 + 4], s[j][8 * s2 + 5]); pw.w = cvtpk(s[j][8 * s2 + 6], s[j][8 * s2 + 7]);
                    const bf16x8 pf = __builtin_bit_cast(bf16x8, pw);
#pragma unroll
                    for (int dt = 0; dt < 2; ++dt) {
                        const LAS unsigned char* vp = lds + AT_VT + (g * 64 + 32 * dt + r32) * AT_VS + (32 * ktl + 16 * s2 + 4 * hi) * 2;
                        const v2u vlo = *(const LAS v2u*)vp, vhi = *(const LAS v2u*)(vp + 16);
                        v4u vw; vw.x = vlo.x; vw.y = vlo.y; vw.z = vhi.x; vw.w = vhi.y;
                        o[dt] = __builtin_amdgcn_mfma_f32_32x32x16_bf16(__builtin_bit_cast(bf16x8, vw), pf, o[dt], 0, 0, 0);
                    }
                }
            }
        }
        const float il = 1.0f / l;
#pragma unroll
        for (int dt = 0; dt < 2; ++dt)
#pragma unroll
            for (int i4 = 0; i4 < 4; ++i4) { const int d0 = 32 * dt + 8 * i4 + 4 * hi; const v2u sg = sgv[dt][i4];
                const float a0 = o[dt][4 * i4 + 0] * il * __uint_as_float(sg.x << 16), a1 = o[dt][4 * i4 + 1] * il * __uint_as_float(sg.x & 0xffff0000u);
                const float a2 = o[dt][4 * i4 + 2] * il * __uint_as_float(sg.y << 16), a3 = o[dt][4 * i4 + 3] * il * __uint_as_float(sg.y & 0xffff0000u);
                v2u ov; ov.x = cvtpk(a0, a1); ov.y = cvtpk(a2, a3);
                ovs[dt][i4] = ov;
                if (!to_lds) *(v2u*)(MIX + qrow * 512 + h * 64 + d0) = ov;
                else if (i == 0) *(LAS v2u*)(lds + AT_LDS + r32 * A_STRIDE + (h * 64 + d0) * 2) = ov; }
    }
    __syncthreads();
    if (to_lds) {
#pragma unroll
        for (int dt = 0; dt < 2; ++dt)
#pragma unroll
            for (int i4 = 0; i4 < 4; ++i4) *(LAS v2u*)(lds + A_ATT + (32 + r32) * A_STRIDE + (h * 64 + 32 * dt + 8 * i4 + 4 * hi) * 2) = ovs[dt][i4];
#pragma unroll
        for (int i = 0; i < 4; ++i) { const int e = tid + 512 * i, r = e >> 6, cc = e & 63;
            *(LAS v4u*)(lds + A_ATT + r * A_STRIDE + cc * 16) = *(const LAS v4u*)(lds + AT_LDS + r * A_STRIDE + cc * 16); }
        LDS_WAIT(); __syncthreads();
    }
}

struct SmpArgs { const bf16 *XR, *SGR, *Q, *KV, *SGA, *WG; const float *state_conv, *state_rnn, *ck, *cv, *conv_w, *conv_b, *b_a, *b_x, *lam, *sinks; bf16* MIX; float* out; };
constexpr int SM_XC = 0, SM_QS = 1024, SM_PS = 2048, SM_XB = 4096, SM_ZS = 4608, SM_KS = 8192, SM_VS = SM_KS + 128 * 65 * 4, SM_LDS = SM_VS + 128 * 64 * 4;
constexpr int BTAB_OFF = 144384;
static_assert(SM_ZS + 2048 <= SM_KS && SM_LDS <= BTAB_OFF && BTAB_OFF + 4096 <= LDSCTL_OFF, "sample lds");
__device__ __forceinline__ void st_wt16(bf16* p, unsigned v) { __hip_atomic_store(p, (bf16)v, __ATOMIC_RELAXED, __HIP_MEMORY_SCOPE_AGENT); }
struct SmpPre { f32x4 kk[4], vv[4]; };
__device__ __forceinline__ void sample_prefetch(SmpPre& p, const float* ck, const float* cv, int b, int g, int tid) {
    const float* ckb = ck + (size_t)b * 16384 + 128 + g * 64; const float* cvb = cv + (size_t)b * 16384 + 128 + g * 64;
#pragma unroll
    for (int i = 0; i < 4; ++i) { const int e0 = tid + 512 * i, e = e0 < 127 * 16 ? e0 : 127 * 16 - 1; const int ww = e >> 4, d = (e & 15) * 4; p.kk[i] = __builtin_nontemporal_load((const f32x4*)(ckb + ww * 128 + d)); p.vv[i] = __builtin_nontemporal_load((const f32x4*)(cvb + ww * 128 + d)); }
}
template <bool PRE>
__device__ __forceinline__ void sample_unit(LAS unsigned char* lds, const LAS float* btab, const SmpArgs& S, int b, int g, unsigned* cnt, const SmpPre& pre) {
    LAS float* xc = (LAS float*)(lds + SM_XC); LAS float* qs = (LAS float*)(lds + SM_QS); LAS float* ps = (LAS float*)(lds + SM_PS); LAS float* Ks = (LAS float*)(lds + SM_KS); LAS float* Vs = (LAS float*)(lds + SM_VS);
    LAS float* zs = (LAS float*)(lds + SM_ZS);
    int tid = threadIdx.x; asm volatile("" : "+v"(tid));
    const int lane = tid & 63, w = __builtin_amdgcn_readfirstlane(tid >> 6);
    const size_t r = (size_t)(MP + b);
    const int t8 = tid & 255, ch = 256 * g + t8;
    const float* ckb = S.ck + (size_t)b * 16384 + 128 + g * 64; const float* cvb = S.cv + (size_t)b * 16384 + 128 + g * 64;
    f32x4 kk[4], vv[4];
    if (PRE) {
#pragma unroll
        for (int i = 0; i < 4; ++i) { kk[i] = pre.kk[i]; vv[i] = pre.vv[i]; }
    } else {
#pragma unroll
        for (int i = 0; i < 4; ++i) { const int e0 = tid + 512 * i, e = e0 < 127 * 16 ? e0 : 127 * 16 - 1; const int ww = e >> 4, d = (e & 15) * 4; kk[i] = __builtin_nontemporal_load((const f32x4*)(ckb + ww * 128 + d)); vv[i] = __builtin_nontemporal_load((const f32x4*)(cvb + ww * 128 + d)); }
    }
    const unsigned x0u = S.XR[r * 512 + ch], qu = S.Q[r * 512 + ch], sgru = S.SGR[r * 512 + ch], sgau = S.SGA[r * 512 + ch];
    const unsigned knu = S.KV[r * 256 + g * 64 + (tid & 63)], vnu = S.KV[r * 256 + 128 + g * 64 + (tid & 63)];
    const float s0 = S.state_conv[(size_t)(b * 3 + 0) * 512 + ch], s1 = S.state_conv[(size_t)(b * 3 + 1) * 512 + ch], s2 = S.state_conv[(size_t)(b * 3 + 2) * 512 + ch];
    const float cw0 = S.conv_w[ch], cw1 = S.conv_w[512 + ch], cw2 = S.conv_w[1024 + ch], cw3 = S.conv_w[1536 + ch], cbv = S.conv_b[ch];
    const float bav = S.b_a[ch], bxv = S.b_x[ch], lamv = S.lam[ch], h0 = S.state_rnn[(size_t)b * 512 + ch];
    const float skv = S.sinks[4 * g + (w & 3)];
    bf16x8 bw[2][4][2];
    { const int nb = 4 * g + (w & 3);
#pragma unroll
      for (int gg = 0; gg < 2; ++gg)
#pragma unroll
        for (int nt = 0; nt < 4; ++nt)
#pragma unroll
            for (int ks = 0; ks < 2; ++ks) bw[gg][nt][ks] = *(const bf16x8*)(S.WG + ((size_t)((nb * 2 + gg) * 64 + nt * 16 + (lane & 15))) * 64 + ks * 32 + 8 * (lane >> 4)); }
    __builtin_amdgcn_sched_barrier(0);
    const float x0 = __uint_as_float(x0u << 16);
    const float xcv = cbv + cw0 * s0 + cw1 * s1 + cw2 * s2 + cw3 * x0;
    if (tid < 256) { xc[t8] = xcv; *(LAS bf16*)(lds + SM_XB + t8 * 2) = (bf16)pg8::cvt_pk_bf16(xcv, 0.f); qs[t8] = __uint_as_float(qu << 16);
        S.out[O_CS + (size_t)(b * 3 + 0) * 512 + ch] = s1; S.out[O_CS + (size_t)(b * 3 + 1) * 512 + ch] = s2; }
    else if (tid < 320) { Ks[127 * 65 + lane] = __uint_as_float(knu << 16); Vs[127 * 64 + lane] = __uint_as_float(vnu << 16); }
#pragma unroll
    for (int i = 0; i < 4; ++i) { const int e = tid + 512 * i; if (e < 127 * 16) { const int ww = e >> 4, d = (e & 15) * 4;
        LAS float* kd = Ks + ww * 65 + d; kd[0] = kk[i].x; kd[1] = kk[i].y; kd[2] = kk[i].z; kd[3] = kk[i].w; *(LAS f32x4*)(Vs + ww * 64 + d) = vv[i]; } }
    __syncthreads();    if (tid < 256) {
        bf16x8 af[2];
#pragma unroll
        for (int ks = 0; ks < 2; ++ks) af[ks] = *(const LAS bf16x8*)(lds + SM_XB + (64 * w + 32 * ks + 8 * (lane >> 4)) * 2);
#pragma unroll
        for (int gg = 0; gg < 2; ++gg)
#pragma unroll
            for (int nt = 0; nt < 4; ++nt) { f32x4 acc = {0.f, 0.f, 0.f, 0.f};
#pragma unroll
                for (int ks = 0; ks < 2; ++ks) acc = __builtin_amdgcn_mfma_f32_16x16x32_bf16(af[ks], bw[gg][nt][ks], acc, 0, 0, 0);
                if (lane < 16) zs[gg * 256 + 64 * w + 16 * nt + lane] = acc[0]; }
        LDS_WAIT(); __builtin_amdgcn_wave_barrier();
        const float rr = rcpf_(1.0f + ex2(zs[t8] - LOG2E * bav)), ig = rcpf_(1.0f + ex2(zs[256 + t8] - LOG2E * bxv));
        const float l2 = rr * (-8.0f * softplus_neg(lamv) * LOG2E); const float a = ex2(l2);
        const float x2 = 1.3862943611198906f * l2;
        const float em_small = -x2 * __builtin_fmaf(__builtin_fmaf(x2, 0.16666667f, 0.5f), x2, 1.0f);
        const float em = (x2 > -0.015625f) ? em_small : __builtin_fmaf(-a, a, 1.0f);
        const float h = a * h0 + __builtin_amdgcn_sqrtf(em) * (ig * xcv);
        S.out[O_RS + (size_t)b * 512 + ch] = h;
        st_wt16(S.MIX + r * DM + ch, pg8::cvt_pk_bf16(h * __uint_as_float(sgru << 16), 0.f));
    }
    {
        const int hh = tid >> 7, ww = tid & 127;
        const LAS float* kp = Ks + ww * 65; const LAS float* qp = qs + hh * 64;
        float sc = 0.f;
#pragma unroll 16
        for (int d = 0; d < 64; ++d) sc += qp[d] * kp[d];
        ps[hh * 128 + ww] = sc + btab[(4 * g + hh) * 128 + 127 - ww];
    }
    __syncthreads();    if (tid < 256) {
        const float sa = ps[w * 128 + lane], sb = ps[w * 128 + 64 + lane];
        const float sk = skv * LOG2E;
        float m = fmaxf(fmaxf(sa, sb), sk);
#pragma unroll
        for (int o2 = 32; o2 > 0; o2 >>= 1) m = fmaxf(m, __shfl_xor(m, o2));
        const float p0 = ex2(sa - m), p1 = ex2(sb - m);
        const float l = wave_sum(p0 + p1) + ex2(sk - m);
        const float il = 1.0f / l;
        ps[w * 128 + lane] = p0 * il; ps[w * 128 + 64 + lane] = p1 * il;
        LDS_WAIT(); __builtin_amdgcn_wave_barrier();
        const LAS float* vp = Vs + lane; const LAS float* pp = ps + w * 128;
        float o = 0.f;
#pragma unroll 16
        for (int k = 0; k < 128; ++k) o += pp[k] * vp[k * 64];
        st_wt16(S.MIX + r * DM + 512 + ch, pg8::cvt_pk_bf16(o * __uint_as_float(sgau << 16), 0.f));
    }
    VM_WAIT(); __syncthreads();    if (tid == 0) __hip_atomic_fetch_add(cnt, 1u, __ATOMIC_RELAXED, __HIP_MEMORY_SCOPE_AGENT);
    {
        float* okb = S.out + O_KS + (size_t)b * 16384 + g * 64; float* ovb = S.out + O_VS + (size_t)b * 16384 + g * 64;
#pragma unroll
        for (int i = 0; i < 4; ++i) { const int e = tid + 512 * i; if (e < 127 * 16) { const int ww = e >> 4, d = (e & 15) * 4; __builtin_nontemporal_store(kk[i], (f32x4*)(okb + ww * 128 + d)); __builtin_nontemporal_store(vv[i], (f32x4*)(ovb + ww * 128 + d)); } }
    }
}

template <int NLOADS>
__device__ __forceinline__ unsigned l2_warm_issue(v4u (&pf)[NLOADS], const void* base, int tid) {
    const char* p = (const char*)base + ((size_t)(((blockIdx.x >> 3) & 31) * 8 + (tid >> 6)) * NLOADS) * 1024 + (tid & 63) * 16;
#pragma unroll
    for (int i = 0; i < NLOADS; ++i) pf[i] = *(const v4u*)(p + i * 1024);
    return 0u;
}
template <int NLOADS>
__device__ __forceinline__ void l2_warm_retire(const v4u (&pf)[NLOADS], unsigned* sink) {
    unsigned a = 0u;
#pragma unroll
    for (int i = 0; i < NLOADS; ++i) a |= pf[i].x ^ pf[i].y ^ pf[i].z ^ pf[i].w;
    if (a == 0x9E3779B9u && threadIdx.x == 12345) *sink = a;
}
constexpr int A_LO = A_RNN, A_HI = A_ATT, A_RS = A_PART;
struct ProjArgs { const float* x; const bf16 *WA, *WB, *WKV; bf16 *XR, *SGR, *Q, *SGA, *KV; float* out; unsigned* sink; bf16* XB2; };
#define AS_LOADB(dst, wfp, NTT, ks) do { _Pragma("unroll") for (int nt = 0; nt < NTT; ++nt) dst[nt] = *(const bf16x8*)((wfp) + (size_t)(((ks) * NTT + nt) * 512)); } while (0)
#define AS_STEP(accv, bw, NTT, ks) do { bf16x8 af[4]; const LAS unsigned char* ap = abase + (((ks) < 16) ? A_LO : A_HI) + (((ks) & 15) * 64); \
        _Pragma("unroll") for (int mt = 0; mt < 4; ++mt) af[mt] = *(const LAS bf16x8*)(ap + mt * 16 * A_STRIDE); \
        _Pragma("unroll") for (int mt = 0; mt < 4; ++mt) _Pragma("unroll") for (int nt = 0; nt < NTT; ++nt) accv[mt][nt] = __builtin_amdgcn_mfma_f32_16x16x32_bf16(bw[nt], af[mt], accv[mt][nt], 0, 0, 0); } while (0)
__device__ __forceinline__ v4u pack8(f32x4 a, f32x4 b) { v4u o; o.x = pg8::cvt_pk_bf16(a.x, a.y); o.y = pg8::cvt_pk_bf16(a.z, a.w); o.z = pg8::cvt_pk_bf16(b.x, b.y); o.w = pg8::cvt_pk_bf16(b.z, b.w); return o; }
__device__ __forceinline__ f32x4 silu4(f32x4 v) { f32x4 o; o.x = silu_(v.x); o.y = silu_(v.y); o.z = silu_(v.z); o.w = silu_(v.w); return o; }
template <int PASS>
__device__ __forceinline__ void proj_pass(const LAS unsigned char* abase, size_t row0, int w, int lane, int fr, int fq, const float (&rs)[4], const bf16* W, bf16* dlo, bf16* dhi, float* out) {
    const bf16* wf = W + (size_t)w * (32 * 8 * 64 * 8) + lane * 8;
    f32x4 acc[4][8];
#pragma unroll
    for (int mt = 0; mt < 4; ++mt)
#pragma unroll
        for (int nt = 0; nt < 8; ++nt) acc[mt][nt] = (f32x4){0.f, 0.f, 0.f, 0.f};
    bf16x8 b0[8], b1[8], b2[8];
    AS_LOADB(b0, wf, 8, 0); AS_LOADB(b1, wf, 8, 1);
#pragma unroll 1
    for (int ks = 0; ks < 30; ks += 3) {
        AS_LOADB(b2, wf, 8, ks + 2); __builtin_amdgcn_sched_barrier(0);
        AS_STEP(acc, b0, 8, ks); __builtin_amdgcn_sched_barrier(0);
        AS_LOADB(b0, wf, 8, ks + 3); __builtin_amdgcn_sched_barrier(0);
        AS_STEP(acc, b1, 8, ks + 1); __builtin_amdgcn_sched_barrier(0);
        AS_LOADB(b1, wf, 8, (ks + 4 < 32 ? ks + 4 : 31)); __builtin_amdgcn_sched_barrier(0);
        AS_STEP(acc, b2, 8, ks + 2); __builtin_amdgcn_sched_barrier(0);
    }
    AS_STEP(acc, b0, 8, 30); __builtin_amdgcn_sched_barrier(0);
    AS_STEP(acc, b1, 8, 31); __builtin_amdgcn_sched_barrier(0);
    bf16* dst = (w < 4) ? dlo : dhi;
    const int colw = 128 * (w & 3) + 8 * fq;
#pragma unroll
    for (int mt = 0; mt < 4; ++mt) { const size_t row = row0 + 16 * mt + fr;
#pragma unroll
        for (int p = 0; p < 4; ++p) { f32x4 v0 = acc[mt][2 * p] * rs[mt], v1 = acc[mt][2 * p + 1] * rs[mt];
            if (w >= 4) { v0 = silu4(v0); v1 = silu4(v1); } else if (PASS) { v0 = v0 * QSCALE; v1 = v1 * QSCALE; }
            if (PASS == 1) { bf16* wp_ = dst + row * 512 + colw + 32 * p; const v4u o_ = pack8(v0, v1); ST_WT128(wp_, o_); }
            else *(v4u*)(dst + row * 512 + colw + 32 * p) = pack8(v0, v1);
            if (PASS == 0 && w < 4) { const int j = (int)(row & (SEQ - 1)) - (SEQ - 3);
                if (j >= 0) { float* o = out + O_CP + (size_t)((row >> 13) * 3 + j) * 512 + colw + 32 * p; *(f32x4*)o = v0; *(f32x4*)(o + 4) = v1; } } } }
}
__device__ __forceinline__ void proj_unit(LAS unsigned char* lds, int u, const ProjArgs& P) {
    int tid = threadIdx.x; asm volatile("" : "+v"(tid));
    const int lane = tid & 63, w = __builtin_amdgcn_readfirstlane(tid >> 6), fr = lane & 15, fq = lane >> 4;
    const size_t row0 = (size_t)u * 64;
    LAS float* rsl = (LAS float*)(lds + A_RS);
    const LAS unsigned char* abase = lds + fr * A_STRIDE + fq * 16;
    if (w < 4) {
        f32x4 xa[16], xb[16]; float ss[16];
        const float* xu = P.x + (row0 + 16 * w) * DM; bf16* xb2u = P.XB2 + (row0 + 16 * w) * DM;
#pragma unroll
        for (int r = 0; r < 16; ++r) ss[r] = 0.f;
#define XC_ISSUE(buf, j) do { _Pragma("unroll") for (int r = 0; r < 16; ++r) buf[r] = __builtin_nontemporal_load((const f32x4*)(xu + (size_t)r * DM + 256 * (j)) + lane); } while (0)
#define XC_CONVERT(buf, j) do { _Pragma("unroll") for (int r = 0; r < 16; ++r) { const int row = 16 * w + r; \
            ss[r] += (buf[r].x * buf[r].x + buf[r].y * buf[r].y) + (buf[r].z * buf[r].z + buf[r].w * buf[r].w); asm volatile("" : "+v"(ss[r])); \
            v2u o; o.x = pg8::cvt_pk_bf16(buf[r].x, buf[r].y); o.y = pg8::cvt_pk_bf16(buf[r].z, buf[r].w); \
            *(LAS v2u*)(lds + ((j) < 2 ? A_LO : A_HI) + row * A_STRIDE + ((4 * lane + 256 * (j)) & 511) * 2) = o; \
            ((v2u*)(xb2u + (size_t)r * DM + 256 * (j)))[lane] = o; } } while (0)
        XC_ISSUE(xa, 0); __builtin_amdgcn_sched_barrier(0); XC_ISSUE(xb, 1); __builtin_amdgcn_sched_barrier(0);
        XC_CONVERT(xa, 0); __builtin_amdgcn_sched_barrier(0); XC_ISSUE(xa, 2); __builtin_amdgcn_sched_barrier(0); LDS_WAIT(); __syncthreads();
        XC_CONVERT(xb, 1); __builtin_amdgcn_sched_barrier(0); XC_ISSUE(xb, 3); __builtin_amdgcn_sched_barrier(0); LDS_WAIT(); __syncthreads();
        XC_CONVERT(xa, 2); __builtin_amdgcn_sched_barrier(0); LDS_WAIT(); __syncthreads();
        v4u pfb0[8], pfb1[8]; l2_warm_issue<8>(pfb0, P.WB, tid); l2_warm_issue<8>(pfb1, P.WB, tid + 256);
        __builtin_amdgcn_sched_barrier(0);
        XC_CONVERT(xb, 3); __builtin_amdgcn_sched_barrier(0);
#undef XC_ISSUE
#undef XC_CONVERT
#pragma unroll
        for (int r = 0; r < 16; ++r) { const float sr = wave_sum(ss[r]); if (lane == 0) rsl[16 * w + r] = rsqrtf(sr * (1.0f / DM) + EPS); }
        LDS_WAIT(); __syncthreads();
        l2_warm_retire<8>(pfb0, P.sink); l2_warm_retire<8>(pfb1, P.sink);
    } else {
        const int mw = w - 4;
        {   v4u pfa0[8], pfa1[8]; l2_warm_issue<8>(pfa0, P.WA, tid); l2_warm_issue<8>(pfa1, P.WA, tid - 256);
            __builtin_amdgcn_sched_barrier(0);
            l2_warm_retire<8>(pfa0, P.sink); l2_warm_retire<8>(pfa1, P.sink); }
        const bf16* wf0 = P.WKV + (size_t)(2 * mw) * (32 * 2 * 64 * 8) + lane * 8;
        const bf16* wf1 = wf0 + (32 * 2 * 64 * 8);
        f32x4 acc[4][4];
#pragma unroll
        for (int mt = 0; mt < 4; ++mt)
#pragma unroll
            for (int nt = 0; nt < 4; ++nt) acc[mt][nt] = (f32x4){0.f, 0.f, 0.f, 0.f};
        bf16x8 bq[4][4];
#define KV_LD(slot, ks) do { bq[slot][0] = *(const bf16x8*)(wf0 + (size_t)((ks) * 2) * 512); bq[slot][1] = *(const bf16x8*)(wf0 + (size_t)((ks) * 2 + 1) * 512); \
                             bq[slot][2] = *(const bf16x8*)(wf1 + (size_t)((ks) * 2) * 512); bq[slot][3] = *(const bf16x8*)(wf1 + (size_t)((ks) * 2 + 1) * 512); } while (0)
        KV_LD(0, 0); KV_LD(1, 1); KV_LD(2, 2); __builtin_amdgcn_sched_barrier(0);
#pragma unroll
        for (int ks = 0; ks < 32; ++ks) {
            if ((ks & 7) == 0) __syncthreads();
            if (ks + 3 < 32) KV_LD((ks + 3) & 3, ks + 3);
            __builtin_amdgcn_sched_barrier(0);
            AS_STEP(acc, bq[ks & 3], 4, ks); __builtin_amdgcn_sched_barrier(0);
        }
#undef KV_LD
#pragma unroll
        for (int sb = 0; sb < 2; ++sb) { const int col = 32 * (2 * mw + sb) + 8 * fq;
#pragma unroll
            for (int mt = 0; mt < 4; ++mt) { const size_t row = row0 + 16 * mt + fr; const int wi = (int)(row & (SEQ - 1)) - (SEQ - WIN); const float rsm = rsl[16 * mt + fr];
                const f32x4 v0 = acc[mt][2 * sb] * rsm, v1 = acc[mt][2 * sb + 1] * rsm;
                *(v4u*)(P.KV + row * 256 + col) = pack8(v0, v1);
                if (wi >= 0) { float* o = P.out + (col < 128 ? O_KP : O_VP) + (size_t)((row >> 13) * WIN + wi) * 128 + (col & 127); *(f32x4*)o = v0; *(f32x4*)(o + 4) = v1; } } }
    }
    float rs[4];
#pragma unroll
    for (int mt = 0; mt < 4; ++mt) rs[mt] = rsl[16 * mt + fr];
    proj_pass<0>(abase, row0, w, lane, fr, fq, rs, P.WA, P.XR, P.SGR, P.out);
    proj_pass<1>(abase, row0, w, lane, fr, fq, rs, P.WB, P.Q, P.SGA, P.out);
    __syncthreads();
}
struct SprojArgs { const bf16* XB; const bf16 *WA, *WB, *WKV; const float* RSTD; bf16 *XR, *SGR, *Q, *KV, *SGA; float* out; };
__device__ __forceinline__ void sample_proj_unit(LAS unsigned char* lds, int sl, const SprojArgs& P) {
    int tid = threadIdx.x; asm volatile("" : "+v"(tid));
    const int lane = tid & 63, w = __builtin_amdgcn_readfirstlane(tid >> 6), fr = lane & 15, fq = lane >> 4;
    const int rg = sl / 36, cg = sl % 36, pass = cg >> 4;
    const bf16* wa_ = P.WA; const bf16* wb_ = P.WB; const bf16* wkv_ = P.WKV;
    const bf16* ap = P.XB + (size_t)(MP + 32 * rg + fr) * DM + 128 * w + 8 * fq;
    bf16x8 af[2][4], bw[4][4];
#pragma unroll
    for (int j = 0; j < 4; ++j) {
        const int slab = pass < 2 ? (cg >> 1) & 7 : 2 * (cg - 32) + (j >> 1), nta = pass < 2 ? 4 * (cg & 1) + j : (j & 1), NTT = pass < 2 ? 8 : 2;
        const bf16* bp = (pass == 0 ? wa_ : pass == 1 ? wb_ : wkv_) + ((size_t)(slab * 32 * NTT + nta) * 64 + lane) * 8;
#pragma unroll
        for (int k = 0; k < 4; ++k) bw[j][k] = *(const bf16x8*)(bp + (size_t)(4 * w + k) * NTT * 512); }
#pragma unroll
    for (int mt = 0; mt < 2; ++mt)
#pragma unroll
        for (int k = 0; k < 4; ++k) af[mt][k] = *(const bf16x8*)(ap + (size_t)(16 * mt) * DM + 32 * k);
    const int tmt = w >> 2, tj = w & 3;
    const float rstd_row = P.RSTD[(size_t)MP + 32 * rg + 16 * tmt + fr];
    __builtin_amdgcn_sched_barrier(0);
    LAS float* red = (LAS float*)lds;
#pragma unroll
    for (int mt = 0; mt < 2; ++mt)
#pragma unroll
        for (int j = 0; j < 4; ++j) { f32x4 acc = {0.f, 0.f, 0.f, 0.f};
#pragma unroll
            for (int k = 0; k < 4; ++k) acc = __builtin_amdgcn_mfma_f32_16x16x32_bf16(bw[j][k], af[mt][k], acc, 0, 0, 0);
            *(LAS f32x4*)(red + ((w * 8 + mt * 4 + j) * 64 + lane) * 4) = acc; }
    LDS_WAIT(); __syncthreads();
    f32x4 v = {0.f, 0.f, 0.f, 0.f};
#pragma unroll
    for (int ww = 0; ww < 8; ++ww) v += *(const LAS f32x4*)(red + ((ww * 8 + w) * 64 + lane) * 4);
    const int b = 32 * rg + 16 * tmt + fr; const size_t row = (size_t)MP + b;
    v = v * rstd_row;
    const int slab = pass < 2 ? (cg >> 1) & 7 : 2 * (cg - 32) + (tj >> 1), nt = pass < 2 ? 4 * (cg & 1) + tj : (tj & 1);
    const int cin = 32 * (nt >> 1) + 8 * fq + 4 * (nt & 1);
    v2u o;
    if (pass < 2) { const int col = 128 * (slab & 3) + cin;
        if (slab >= 4) v = silu4(v); else if (pass) v = v * QSCALE;
        o.x = pg8::cvt_pk_bf16(v.x, v.y); o.y = pg8::cvt_pk_bf16(v.z, v.w);
        bf16* q_ = P.Q; bf16* sga_ = P.SGA; bf16* xr_ = P.XR; bf16* sgr_ = P.SGR;
        bf16* dst = pass ? (slab < 4 ? q_ : sga_) : (slab < 4 ? xr_ : sgr_);
        *(v2u*)(dst + row * 512 + col) = o;
        if (pass == 0 && slab < 4) *(f32x4*)(P.out + O_CS + (size_t)(b * 3 + 2) * 512 + col) = v; }
    else { const int col = 32 * slab + cin;
        o.x = pg8::cvt_pk_bf16(v.x, v.y); o.y = pg8::cvt_pk_bf16(v.z, v.w);
        *(v2u*)(P.KV + row * 256 + col) = o;
        *(f32x4*)(P.out + (col < 128 ? O_KS : O_VS) + (size_t)b * 16384 + 127 * 128 + (col & 127)) = v; }
    __syncthreads();
}

__device__ __forceinline__ void out_unit(LAS unsigned char* lds, int b, int c, const unsigned* UV, const bf16* ATT, const float* AGG, const float* GA, const bf16* WF, const bf16* x, const float* gpost, float* y, float* out, bool att_in_lds) {
    int tid = threadIdx.x; asm volatile("" : "+v"(tid));
    const int lane = tid & 63, w = __builtin_amdgcn_readfirstlane(tid >> 6), fr = lane & 15, fq = lane >> 4;
    const size_t row0 = (size_t)b * SEQ + 64 * c;
    typedef f16 f16x8 __attribute__((ext_vector_type(8)));
    f16x8 p0[8], p1[8];
#pragma unroll
    for (int i = 0; i < 8; ++i) { const int e = tid + 512 * i, r = e >> 6, cc = e & 63;
        p0[i] = *(const f16x8*)(UV + (row0 + r) * 512 + cc * 8); p1[i] = *(const f16x8*)(UV + (row0 + r) * 512 + cc * 8 + 4); }
    v4u pfo[8]; l2_warm_issue<8>(pfo, WF, tid);
    __builtin_amdgcn_sched_barrier(0);
    {
        const float* ag = AGG + (size_t)b * NCHUNK * 1024 + tid; const float* gg = GA + (size_t)b * 16 * 1024 + tid;
        const int g = c >> 3;
        float ga[15], gb[15], ta[7], tb[7];
#pragma unroll
        for (int jj = 0; jj < 15; ++jj) { const int j = jj < g ? jj : (g > 0 ? g - 1 : 0); ga[jj] = ldf_sc1(gg + (size_t)j * 1024); gb[jj] = ldf_sc1(gg + (size_t)j * 1024 + 512); }
#pragma unroll
        for (int jj = 0; jj < 7; ++jj) { const int j = (8 * g + jj < c) ? 8 * g + jj : (c > 0 ? c - 1 : 0); ta[jj] = ldf_sc1(ag + (size_t)j * 1024); tb[jj] = ldf_sc1(ag + (size_t)j * 1024 + 512); }
        const float ca = ldf_sc1(ag + (size_t)c * 1024), cb = ldf_sc1(ag + (size_t)c * 1024 + 512);
        __builtin_amdgcn_sched_barrier(0);
        float hin = 0.f;
#pragma unroll
        for (int jj = 0; jj < 15; ++jj) if (jj < g) hin = ga[jj] * hin + gb[jj];
#pragma unroll
        for (int jj = 0; jj < 7; ++jj) if (8 * g + jj < c) hin = ta[jj] * hin + tb[jj];
        ((LAS float*)(lds + A_HIN))[tid] = hin;
        l2_warm_retire<8>(pfo, (unsigned*)(out + O_RP));
        if (c == NCHUNK - 1) out[O_RP + b * 512 + tid] = ca * hin + cb;
    }
    VM_WAIT(); __syncthreads();
    {   v4u at[8];
#pragma unroll
        for (int i = 0; i < 8; ++i) { const int e = tid + 512 * i, r = e >> 6, cc = e & 63;
            at[i] = *(const v4u*)(ATT + (row0 + (att_in_lds ? 0 : r)) * 512 + cc * 8); }
        __builtin_amdgcn_sched_barrier(0);
        LDS_WAIT(); __syncthreads();
#pragma unroll
        for (int i = 0; i < 8; ++i) { const int e = tid + 512 * i, r = e >> 6, cc = e & 63;
            const f32x4 h0 = *(const LAS f32x4*)(lds + A_HIN + cc * 32), h1 = *(const LAS f32x4*)(lds + A_HIN + cc * 32 + 16);
            v4u o; o.x = pg8::cvt_pk_bf16((float)p0[i][0] + (float)p0[i][1] * h0.x, (float)p0[i][2] + (float)p0[i][3] * h0.y); o.y = pg8::cvt_pk_bf16((float)p0[i][4] + (float)p0[i][5] * h0.z, (float)p0[i][6] + (float)p0[i][7] * h0.w);
            o.z = pg8::cvt_pk_bf16((float)p1[i][0] + (float)p1[i][1] * h1.x, (float)p1[i][2] + (float)p1[i][3] * h1.y); o.w = pg8::cvt_pk_bf16((float)p1[i][4] + (float)p1[i][5] * h1.z, (float)p1[i][6] + (float)p1[i][7] * h1.w);
            *(LAS v4u*)(lds + A_RNN + r * A_STRIDE + cc * 16) = o; if (!att_in_lds) *(LAS v4u*)(lds + A_ATT + r * A_STRIDE + cc * 16) = at[i]; }
    }
    LDS_WAIT(); __syncthreads();
    f32x4 acc[4][8];
#pragma unroll
    for (int mt = 0; mt < 4; ++mt)
#pragma unroll
        for (int nt = 0; nt < 8; ++nt) acc[mt][nt] = (f32x4){0.f, 0.f, 0.f, 0.f};
    const bf16* wf = WF + (size_t)w * (32 * 8 * 64 * 8) + lane * 8;
    const LAS unsigned char* abase = lds + fr * A_STRIDE + fq * 16;
    bf16x8 b0[8], b1[8];
#define OU_LOADB(dst, ks) do { _Pragma("unroll") for (int nt = 0; nt < 8; ++nt) dst[nt] = *(const bf16x8*)(wf + (size_t)(((ks) * 8 + nt) * 512)); } while (0)
#define OU_STEP(bw, ks) do { bf16x8 af[4]; const LAS unsigned char* ap = abase + (((ks) < 16) ? A_RNN : A_ATT) + (((ks) & 15) * 64); \
        _Pragma("unroll") for (int mt = 0; mt < 4; ++mt) af[mt] = *(const LAS bf16x8*)(ap + mt * 16 * A_STRIDE); \
        _Pragma("unroll") for (int mt = 0; mt < 4; ++mt) _Pragma("unroll") for (int nt = 0; nt < 8; ++nt) acc[mt][nt] = __builtin_amdgcn_mfma_f32_16x16x32_bf16(bw[nt], af[mt], acc[mt][nt], 0, 0, 0); } while (0)
    OU_LOADB(b0, 0);
#pragma unroll 1
    for (int ks = 0; ks < 32; ks += 2) {
        OU_LOADB(b1, ks + 1); __builtin_amdgcn_sched_barrier(0);
        OU_STEP(b0, ks); __builtin_amdgcn_sched_barrier(0);
        OU_LOADB(b0, (ks + 2 < 32 ? ks + 2 : 31)); __builtin_amdgcn_sched_barrier(0);
        OU_STEP(b1, ks + 1); __builtin_amdgcn_sched_barrier(0);
    }
#undef OU_LOADB
#undef OU_STEP
    int tid2 = threadIdx.x; asm volatile("" : "+v"(tid2)); const int fr2 = tid2 & 15, fq2 = (tid2 >> 4) & 3;
    const int lane2 = tid2 & 63;
    v2u xv[4][2][4];
    { const bf16* xb0 = x + (row0 + 2 * w) * DM + 4 * lane2;
#pragma unroll
      for (int mt = 0; mt < 4; ++mt)
#pragma unroll
        for (int rr = 0; rr < 2; ++rr)
#pragma unroll
            for (int j = 0; j < 4; ++j) xv[mt][rr][j] = __builtin_nontemporal_load((const v2u*)(xb0 + (size_t)(16 * mt + rr) * DM + 256 * j)); }
    __builtin_amdgcn_sched_barrier(0);
    LAS float* part = (LAS float*)(lds + A_PART);
#pragma unroll
    for (int mt = 0; mt < 4; ++mt) { float ss = 0.f;
#pragma unroll
        for (int nt = 0; nt < 8; ++nt) { const f32x4 v = acc[mt][nt]; ss += (v.x * v.x + v.y * v.y) + (v.z * v.z + v.w * v.w); }
        ss += __shfl_xor(ss, 16); ss += __shfl_xor(ss, 32);
        if (fq2 == 0) part[w * 64 + 16 * mt + fr2] = ss; }
    LDS_WAIT(); __syncthreads();
    constexpr int YS = 4112;
    f32x4 gv[4];
#pragma unroll
    for (int j = 0; j < 4; ++j) gv[j] = *(const f32x4*)(gpost + 4 * lane2 + 256 * j);
#pragma unroll
    for (int mt = 0; mt < 4; ++mt) { float ss = 0.f;
#pragma unroll
        for (int ww = 0; ww < 8; ++ww) ss += part[ww * 64 + 16 * mt + fr2];
        const float rs = rsqrtf(ss * (1.0f / DM) + EPS);
#pragma unroll
        for (int nt = 0; nt < 8; ++nt) *(LAS f32x4*)(lds + fr2 * YS + (128 * w + 16 * nt + 4 * fq2) * 4) = acc[mt][nt] * rs;
        LDS_WAIT(); __syncthreads();
#pragma unroll
        for (int rr = 0; rr < 2; ++rr)
#pragma unroll
            for (int j = 0; j < 4; ++j) { const f32x4 v = *(const LAS f32x4*)(lds + (2 * w + rr) * YS + (4 * lane2 + 256 * j) * 4);
                const v2u xq = xv[mt][rr][j]; const f32x4 xf = {__uint_as_float(xq.x << 16), __uint_as_float(xq.x & 0xffff0000u), __uint_as_float(xq.y << 16), __uint_as_float(xq.y & 0xffff0000u)};
                __builtin_nontemporal_store(xf + v * gv[j], (f32x4*)(y + (row0 + 16 * mt + 2 * w + rr) * DM + 4 * lane2 + 256 * j)); }
        LDS_WAIT(); __syncthreads(); }
}
typedef unsigned long long u64x2 __attribute__((ext_vector_type(2)));
__device__ __forceinline__ u64x2 ld16_sc1(const void* p) { const unsigned long long* q = (const unsigned long long*)p;
    u64x2 r; r.x = __hip_atomic_load(q, __ATOMIC_RELAXED, __HIP_MEMORY_SCOPE_AGENT); r.y = __hip_atomic_load(q + 1, __ATOMIC_RELAXED, __HIP_MEMORY_SCOPE_AGENT); return r; }
__device__ __forceinline__ void sample_out_unit(LAS unsigned char* lds, int su, const bf16* MIX, const bf16* WF, float* OUTS) {
    int tid = threadIdx.x; asm volatile("" : "+v"(tid));
    const int lane = tid & 63, w = __builtin_amdgcn_readfirstlane(tid >> 6), fr = lane & 15, fq = lane >> 4;
    const int rg = su >> 5, cg = su & 31;
    const bf16* bp = WF + ((size_t)((cg >> 2) * 32 * 8 + 2 * (cg & 3)) * 64 + lane) * 8;
    const bf16* ap = MIX + (size_t)(MP + 32 * rg + fr) * DM + 128 * w + 8 * fq;
    bf16x8 af[2][4], bw[2][4];
#pragma unroll
    for (int k = 0; k < 4; ++k) {
#pragma unroll
        for (int j = 0; j < 2; ++j) bw[j][k] = *(const bf16x8*)(bp + (size_t)(4 * w + k) * 8 * 512 + j * 512);
#pragma unroll
        for (int mt = 0; mt < 2; ++mt) af[mt][k] = *(const bf16x8*)(ap + (size_t)(16 * mt) * DM + 32 * k); }
    __builtin_amdgcn_sched_barrier(0);
    LAS float* red = (LAS float*)lds;
#pragma unroll
    for (int mt = 0; mt < 2; ++mt)
#pragma unroll
        for (int j = 0; j < 2; ++j) { f32x4 acc = {0.f, 0.f, 0.f, 0.f};
#pragma unroll
            for (int k = 0; k < 4; ++k) acc = __builtin_amdgcn_mfma_f32_16x16x32_bf16(bw[j][k], af[mt][k], acc, 0, 0, 0);
            *(LAS f32x4*)(red + ((w * 4 + mt * 2 + j) * 64 + lane) * 4) = acc; }
    LDS_WAIT(); __syncthreads();
    f32x4 v = {0.f, 0.f, 0.f, 0.f};
    if (w < 4) {
#pragma unroll
    for (int ww = 0; ww < 8; ++ww) v += *(const LAS f32x4*)(red + ((ww * 4 + w) * 64 + lane) * 4);
    { float* op = OUTS + (size_t)(32 * rg + 16 * (w >> 1) + fr) * DM + 128 * (cg >> 2) + 16 * (2 * (cg & 3) + (w & 1)) + 4 * fq;
      asm volatile("global_store_dwordx4 %0, %1, off sc0 sc1\n\ts_nop 1" :: "v"(op), "v"(v) : "memory"); }
    }
    __syncthreads();
}

#ifndef MK_N_LAUNCHES
#define MK_N_LAUNCHES 1
#endif
constexpr int N_PHASES = 3;
struct Args { const float* in[19]; float* out; unsigned char* ws; int ph_lo, ph_hi; };
static_assert(sizeof(Args) == 19 * 8 + 8 + 8 + 8, "Args has no padding");

__global__ void __launch_bounds__(512, 2) mk_fwd(Args args) {
    extern __shared__ __attribute__((aligned(16))) unsigned char lds_raw[];
    LAS unsigned char* lds = (LAS unsigned char*)lds_raw;
    volatile LAS unsigned* MISC = (volatile LAS unsigned*)(lds + MISC_OFF);
    const int tid0 = threadIdx.x, wave = __builtin_amdgcn_readfirstlane(tid0 >> 6);
    const int G = gridDim.x, bid = blockIdx.x;
#define PHASE_TID() int tid = tid0; asm volatile("" : "+v"(tid)); const int lane = tid & 63; (void)lane
    unsigned char* ws = args.ws; float* out = args.out;
    const float* x_prompt = args.in[0]; const float* x_sample = args.in[1]; const float* state_conv = args.in[2]; const float* state_rnn = args.in[3];
    const float* cache_k = args.in[4]; const float* cache_v = args.in[5]; const float* norm_pre = args.in[6]; const float* norm_post = args.in[7];
    const float* w_in = args.in[8]; const float* conv_w = args.in[9]; const float* conv_b = args.in[10]; const float* w_a = args.in[11]; const float* b_a = args.in[12];
    const float* w_x = args.in[13]; const float* b_x = args.in[14]; const float* lam = args.in[15]; const float* sinks = args.in[16]; const float* rel_bias = args.in[17];
    const float* w_out = args.in[18];
    bf16* WA = (bf16*)(ws + WS_WA); bf16* WB = (bf16*)(ws + WS_WB); bf16* WT_OUT = (bf16*)(ws + WS_WOUT); bf16* WG = (bf16*)(ws + WS_WG); bf16* WKV = (bf16*)(ws + WS_WKV); float* RSTD = (float*)(ws + WS_RSTD); float* AGG = (float*)(ws + WS_AGG);
    bf16* XB = (bf16*)(ws + WS_XB); bf16* XR = (bf16*)(ws + WS_XR); bf16* SGR = (bf16*)(ws + WS_SGR); bf16* Qb = (bf16*)(ws + WS_Q); bf16* SGA = (bf16*)(ws + WS_SGA);
    bf16* KV = (bf16*)(ws + WS_KV); bf16* MIX = (bf16*)(ws + WS_MIX); float* OUTS = (float*)(ws + WS_OUTS);
    unsigned* ctl = (unsigned*)(ws + WS_CTL);

    if (wave >= 4) __builtin_amdgcn_s_setprio(1);
    for (int u = tid0; u < (LDS_BYTES - LDSCTL_OFF) / 4; u += 512) ((LAS unsigned*)(lds + LDSCTL_OFF))[u] = 0u;
    __syncthreads();
    XcdBarrier bar; bar.bar = ctl + CW_BAR; bar.x = 0; bar.st = nullptr;
    if (MK_N_LAUNCHES == 1) bar = xcd_barrier_post(ctl + CW_BAR, MISC + 8);
    const int lo = args.ph_lo, hi = args.ph_hi;
    SmpPre spre;
#pragma unroll
    for (int i = 0; i < 4; ++i) { spre.kk[i] = (f32x4){0.f, 0.f, 0.f, 0.f}; spre.vv[i] = (f32x4){0.f, 0.f, 0.f, 0.f}; }
#define IN(k) (lo <= (k) && (k) < hi)
#define BOTH(k) (IN(k) && IN((k) + 1))
#define GRID_BAR() do { if (MK_N_LAUNCHES == 1) xcd_barrier(bar); } while (0)

    if (IN(0)) {
        PHASE_TID();
        LAS float* scr = (LAS float*)(lds + wave * 16384);
        const int gw = wave * G + bid, NGW = G * 8;
        constexpr int I_IN = (DM / 64) * (DIN / 32), I_OUT = (DM / 64) * (DM / 32), I_G = 16 * 2;
        for (int it = gw; it < I_IN + I_OUT + I_G; it += NGW) {
            int r = it;
            if (r < I_IN) { const int n0 = 32 * (r % (DIN / 32));
                if (n0 < 1024) p0_transpose_item<3>(w_in, DM, DIN, WA, norm_pre, scr, r, lane, n0);
                else if (n0 < 1536) p0_transpose_item<3>(w_in, DM, DIN, WB, norm_pre, scr, r, lane, n0 - 1024);
                else if (n0 < 1792) p0_transpose_item<4>(w_in, DM, DIN, WKV, norm_pre, scr, r, lane, n0 - 1536);
                else p0_transpose_item<3>(w_in, DM, DIN, WB, norm_pre, scr, r, lane, n0 - 1792 + 512);
                continue; } r -= I_IN;
            if (r < I_OUT) { p0_transpose_item<1>(w_out, DM, DM, WT_OUT, nullptr, scr, r, lane, 32 * (r % (DM / 32))); continue; } r -= I_OUT;
            { const int mat = r >> 1, blk = mat >> 1, gate = mat & 1; p0_transpose_item<0>((gate ? w_x : w_a) + blk * 4096, 64, 64, WG + (size_t)mat * 4096, nullptr, scr, r & 1, lane, 32 * (r & 1), -LOG2E); }
        }
        for (int m0 = MP + (NGW - 1 - gw) * 8; m0 < MT; m0 += NGW * 8) {
            const float* xr[8]; bf16* orow[8]; float* rsp[8];
#pragma unroll
            for (int r = 0; r < 8; ++r) { const int m = m0 + r; xr[r] = x_sample + (size_t)(m - MP) * DM; orow[r] = XB + (size_t)m * DM; rsp[r] = RSTD + m; }
            p0_rows<8>(xr, orow, rsp, lane);
        }
        if (BOTH(0)) GRID_BAR();
    }
    if (IN(1)) {
        {
            ProjArgs PA{x_prompt, WA, WB, WKV, XR, SGR, Qb, SGA, KV, out, ctl + 960, (bf16*)(ws + WS_XB2)};
            SprojArgs SP{XB, WA, WB, WKV, RSTD, XR, SGR, Qb, KV, SGA, out};
            const int nsl = DIN / 16;
            const int sl_first = ((bid & 1) && (bid >> 1) < 128) ? (bid >> 1) : -1, sl_last = (!(bid & 1) && (bid >> 1) < nsl - 128 && G >= 256) ? 128 + (bid >> 1) : -1;
            if (G >= 256) { if (sl_first >= 0) sample_proj_unit(lds, sl_first, SP); }
            else for (int sl = bid; sl < nsl; sl += G) sample_proj_unit(lds, sl, SP);
            for (int u = bid; u < MP / 64; u += G) proj_unit(lds, u, PA);
            if (sl_last >= 0) sample_proj_unit(lds, sl_last, SP);
        }
        if (BOTH(1)) {
            PHASE_TID();
            XbTicket tk; tk.gen = 0u; tk.tg = 0u; tk.role = 0u;
            if (MK_N_LAUNCHES == 1) { VM_WAIT(); __syncthreads(); if (tid0 == 0) tk = xcd_barrier_arrive(bar); }
            LAS float* btab0 = (LAS float*)(lds + BTAB_OFF);
            for (int e = tid; e < 1024; e += 512) { const int h = e >> 7, d = e & 127; btab0[e] = rel_bias[t5_bucket(d) * NH + h] * LOG2E; }
            attn_table(lds, rel_bias);
            if (bid < 2 * DECB && !(G >= 256 && ((bid >> 1) & 1))) sample_prefetch(spre, cache_k, cache_v, bid >> 1, bid & 1, tid);
            if (MK_N_LAUNCHES == 1) { if (tid0 == 0) xcd_barrier_wait(bar, tk); __syncthreads(); }
        }
    }
    if (IN(2)) {
        LAS float* btab = (LAS float*)(lds + BTAB_OFF);
        const bool pre_ok = BOTH(1);
        if (!pre_ok) { PHASE_TID(); for (int e = tid; e < 1024; e += 512) { const int h = e >> 7, d = e & 127; btab[e] = rel_bias[t5_bucket(d) * NH + h] * LOG2E; } }
        __syncthreads();
        RgArgs R{XR, SGR, WG, conv_w, conv_b, b_a, b_x, lam, AGG, (unsigned*)XB};
        SmpArgs SA{XR, SGR, Qb, KV, SGA, WG, state_conv, state_rnn, cache_k, cache_v, conv_w, conv_b, b_a, b_x, lam, sinks, MIX, out};
        const bool r_first = G >= 256 && ((bid >> 1) & 1);
        if (!r_first) {
            if (pre_ok && bid < 2 * DECB) { sample_unit<true>(lds, btab, SA, bid >> 1, bid & 1, ctl + CW_SMP, spre);
                for (int u = bid + G; u < 2 * DECB; u += G) sample_unit<false>(lds, btab, SA, u >> 1, u & 1, ctl + CW_SMP, spre); }
            else for (int u = bid; u < 2 * DECB; u += G) sample_unit<false>(lds, btab, SA, u >> 1, u & 1, ctl + CW_SMP, spre);
        }
        for (int u = bid; u < BATCH * NCHUNK; u += G) { rglru_unit(lds, R, u / NCHUNK, u % NCHUNK);
            if (tid0 == 0) __hip_atomic_fetch_add(ctl + CW_AGG, 1u, __ATOMIC_RELAXED, __HIP_MEMORY_SCOPE_AGENT); }
        if (r_first) for (int u = bid; u < 2 * DECB; u += G) sample_unit<false>(lds, btab, SA, u >> 1, u & 1, ctl + CW_SMP, spre);
        {
            float* GAw = (float*)(ws + WS_GA);
            const bool dsg = G >= 256 ? ((bid & 7) == 5 && bid < BATCH * NCHUNK) : true;
            bool waited_a = false;
            for (int gi = G >= 256 ? (bid >> 3) : bid; dsg && gi < BATCH * 16; gi += G) {
                if (!waited_a) { if (tid0 == 0) { unsigned sp = 0; while (__hip_atomic_load(ctl + CW_AGG, __ATOMIC_RELAXED, __HIP_MEMORY_SCOPE_AGENT) < (unsigned)(BATCH * NCHUNK)) { __builtin_amdgcn_s_sleep(2); if (++sp > (1u << 22)) break; } }
                    __syncthreads(); waited_a = true; }
                const float* ag = AGG + ((size_t)(gi >> 4) * NCHUNK + 8 * (gi & 15)) * 1024 + threadIdx.x;
                float a8[8], h8[8];
#pragma unroll
                for (int j = 0; j < 8; ++j) { a8[j] = ldf_sc1(ag + (size_t)j * 1024); h8[j] = ldf_sc1(ag + (size_t)j * 1024 + 512); }
                float A = 1.f, B = 0.f;
#pragma unroll
                for (int j = 0; j < 8; ++j) { B = a8[j] * B + h8[j]; A *= a8[j]; }
                float* go = GAw + (size_t)gi * 1024 + threadIdx.x;
                __hip_atomic_store(go, A, __ATOMIC_RELAXED, __HIP_MEMORY_SCOPE_AGENT); __hip_atomic_store(go + 512, B, __ATOMIC_RELAXED, __HIP_MEMORY_SCOPE_AGENT);
                VM_WAIT(); __syncthreads();
                if (tid0 == 0) __hip_atomic_fetch_add(ctl + CW_GA, 1u, __ATOMIC_RELAXED, __HIP_MEMORY_SCOPE_AGENT);
            }
        }
        {
            bool waited = false;
            const int sob = G >= 256 ? 128 : 0;
            for (int su = bid - sob; su >= 0 && su < 128; su += G) {
                if (!waited) {
                    if (tid0 == 0) { unsigned sp = 0; while (__hip_atomic_load(ctl + CW_SMP, __ATOMIC_RELAXED, __HIP_MEMORY_SCOPE_AGENT) < (unsigned)(2 * DECB)) { __builtin_amdgcn_s_sleep(2); if (++sp > (1u << 22)) break; }
                        __builtin_amdgcn_fence(__ATOMIC_ACQUIRE, "agent"); VM_WAIT(); }
                    __syncthreads(); waited = true; }
                sample_out_unit(lds, su, MIX, WT_OUT, OUTS);
                VM_WAIT(); __syncthreads();
                if (tid0 == 0) __hip_atomic_fetch_add(ctl + CW_OUTS, 1u, __ATOMIC_RELAXED, __HIP_MEMORY_SCOPE_AGENT);
            }
        }
        for (int u = bid; u < BATCH * NCHUNK; u += G) attn_unit(lds, u / NCHUNK, u % NCHUNK, Qb, KV, SGA, sinks, rel_bias, Qb, !(pre_ok && u == bid), BATCH * NCHUNK <= G);
        {
            if (tid0 == 0) { unsigned sp = 0; while (__hip_atomic_load(ctl + CW_AGG, __ATOMIC_RELAXED, __HIP_MEMORY_SCOPE_AGENT) < (unsigned)(BATCH * NCHUNK) || __hip_atomic_load(ctl + CW_GA, __ATOMIC_RELAXED, __HIP_MEMORY_SCOPE_AGENT) < (unsigned)(BATCH * 16)) { __builtin_amdgcn_s_sleep(2); if (++sp > (1u << 22)) break; } }
            __syncthreads();
        }
        for (int u = bid; u < BATCH * NCHUNK; u += G) out_unit(lds, u / NCHUNK, u % NCHUNK, (const unsigned*)XB, Qb, AGG, (const float*)(ws + WS_GA), WT_OUT, (const bf16*)(ws + WS_XB2), norm_post, out + O_YP, out, BATCH * NCHUNK <= G);
        if (bid < DECB) {
            if (tid0 == 0) { unsigned sp = 0; while (__hip_atomic_load(ctl + CW_OUTS, __ATOMIC_RELAXED, __HIP_MEMORY_SCOPE_AGENT) < 128u) { __builtin_amdgcn_s_sleep(2); if (++sp > (1u << 22)) break; } }
            __syncthreads();
            int tl_ = tid0; asm volatile("" : "+v"(tl_)); const int lane = tl_ & 63;
            for (int b = bid; b < DECB; b += G) if (wave == 0) {
                const f32x4* r4 = (const f32x4*)(OUTS + (size_t)b * DM) + lane; const f32x4* x4 = (const f32x4*)(x_sample + (size_t)b * DM) + lane; f32x4* y4 = (f32x4*)(out + O_YS + (size_t)b * DM) + lane;
                f32x4 v[4]; float ss = 0.f;
#pragma unroll
                for (int j = 0; j < 4; ++j) { v[j] = __builtin_bit_cast(f32x4, ld16_sc1(r4 + 64 * j)); ss += (v[j].x * v[j].x + v[j].y * v[j].y) + (v[j].z * v[j].z + v[j].w * v[j].w); }
                const float rs = rsqrtf(wave_sum(ss) * (1.0f / DM) + EPS);
#pragma unroll
                for (int j = 0; j < 4; ++j) { const f32x4 gg = ((const f32x4*)norm_post)[lane + 64 * j]; y4[64 * j] = x4[64 * j] + v[j] * rs * gg; }
            }
        }
    }
#undef IN
#undef BOTH
#undef GRID_BAR
}

extern "C" void kernel_launch(void* const* d_in, const int* in_sizes, int n_in, void* d_out, int out_size, void* d_ws, size_t ws_size, hipStream_t stream) {
    static int grid = 0;
    if (grid == 0) {
        int dev = 0, cus = 0;
        if (hipGetDevice(&dev) != hipSuccess || hipDeviceGetAttribute(&cus, hipDeviceAttributeMultiprocessorCount, dev) != hipSuccess) { fprintf(stderr, "kernel_launch: device query failed\n"); grid = -1; return; }
        if (hipFuncSetAttribute((const void*)mk_fwd, hipFuncAttributeMaxDynamicSharedMemorySize, LDS_BYTES) != hipSuccess) { fprintf(stderr, "kernel_launch: hipFuncSetAttribute failed\n"); grid = -1; return; }
        int per_cu = 0;
        if (hipOccupancyMaxActiveBlocksPerMultiprocessor(&per_cu, (const void*)mk_fwd, 512, LDS_BYTES) != hipSuccess || per_cu < 1) { fprintf(stderr, "kernel_launch: occupancy query says %d blocks/CU\n", per_cu); }
        (void)hipGetLastError();
        grid = cus;
    }
    if (grid < 0) return;
    (void)hipMemsetAsync((char*)d_ws + WS_CTL, 0, CTL_ZERO_BYTES, stream);
    Args a{};
    for (int i = 0; i < 19; ++i) a.in[i] = (const float*)d_in[i];
    a.out = (float*)d_out; a.ws = (unsigned char*)d_ws;
    if (MK_N_LAUNCHES == 1) { a.ph_lo = 0; a.ph_hi = N_PHASES; hipLaunchKernelGGL(mk_fwd, dim3(grid), dim3(512), LDS_BYTES, stream, a); }
    else for (int p = 0; p < N_PHASES; ++p) { a.ph_lo = p; a.ph_hi = p + 1; hipLaunchKernelGGL(mk_fwd, dim3(grid), dim3(512), LDS_BYTES, stream, a); }
}
```
